# Optimizing an MI355X kernel written in HIP

```python
import jax, jax.numpy as jnp
from jax import lax
import numpy as np

D_MODEL = 1024
BATCH = 8
SEQ = 2048
DEPTH = 1
DEC_BATCH = 128
DEC_SEQ = 1
PAST_LEN = 16384
PAGE_SIZE = 128

RET_HEADS = 4
RET_DK = D_MODEL // 8
RET_DV = D_MODEL // 8
RET_W = RET_HEADS * RET_DK
RET_VW = RET_HEADS * RET_DV
RET_CHUNK = 128
ROPE_BASE = 10000.0
CONV_W = D_MODEL // 2
CONV_K = 31
MEM_HEADS = 4
MEM_DH = D_MODEL // 8
MEM_W = MEM_HEADS * MEM_DH
N_MEM = 256
N_BRANCH = 3
IN_W = 2 * RET_W + 2 * RET_VW + 3 * CONV_W + 2 * MEM_W + N_BRANCH * D_MODEL
EPS = 1e-6

kernel_name = 'retnet_conformer_memxattn_gated_hybrid_step'

F32 = jnp.float32


def _rmsnorm(x, w):
    xf = x.astype(F32)
    y = xf * lax.rsqrt(jnp.mean(xf * xf, axis=-1, keepdims=True) + EPS)
    return (y * w.astype(F32)).astype(x.dtype)


def _layernorm(x, w, b):
    xf = x.astype(F32)
    mu = jnp.mean(xf, axis=-1, keepdims=True)
    xc = xf - mu
    var = jnp.mean(xc * xc, axis=-1, keepdims=True)
    y = xc * lax.rsqrt(var + EPS) * w.astype(F32) + b.astype(F32)
    return y.astype(x.dtype)


def _rotary(x, pos):
    half = x.shape[-1] // 2
    inv = ROPE_BASE ** (-jnp.arange(half, dtype=F32) / half)
    ang = pos[:, None] * inv[None, :]
    cos = jnp.cos(ang)[None, :, None, :]
    sin = jnp.sin(ang)[None, :, None, :]
    x1, x2 = x[..., :half], x[..., half:]
    return jnp.concatenate([x1 * cos - x2 * sin, x1 * sin + x2 * cos], axis=-1)


def _retention(q, k, v, s0):
    B, T, H, _ = q.shape
    DV = v.shape[-1]
    C = RET_CHUNK if T % RET_CHUNK == 0 else T
    n = T // C
    log_g = jnp.log1p(-jnp.exp2(-5.0 - jnp.arange(H, dtype=F32)))
    idx = jnp.arange(C, dtype=F32)
    diff = idx[:, None] - idx[None, :]
    intra = jnp.where(diff >= 0,
                      jnp.exp(jnp.maximum(diff, 0.0)[None] * log_g[:, None, None]),
                      0.0)
    q_dec = jnp.exp((idx + 1.0)[None, :] * log_g[:, None])
    k_dec = jnp.exp((C - 1.0 - idx)[None, :] * log_g[:, None])
    c_dec = jnp.exp(C * log_g)

    def to_chunks(a):
        return a.reshape(B, n, C, H, a.shape[-1]).transpose(1, 0, 3, 2, 4)

    def step(s, blk):
        qc, kc, vc = blk
        sc = jnp.einsum('bhid,bhjd->bhij', qc, kc) * intra[None]
        o = (jnp.einsum('bhij,bhje->bhie', sc, vc)
             + jnp.einsum('bhid,bhde->bhie', qc, s) * q_dec[None, :, :, None])
        s = (s * c_dec[None, :, None, None]
             + jnp.einsum('bhjd,bhje->bhde', kc * k_dec[None, :, :, None], vc))
        return s, o

    s_fin, o = lax.scan(step, s0.astype(F32), (to_chunks(q), to_chunks(k), to_chunks(v)))
    o = o.transpose(1, 0, 3, 2, 4).reshape(B, T, H, DV)
    return o, s_fin


def _group_norm_heads(o, w):
    B, T, H, DV = o.shape
    mu = jnp.mean(o, axis=-1, keepdims=True)
    oc = o - mu
    var = jnp.mean(oc * oc, axis=-1, keepdims=True)
    y = (oc * lax.rsqrt(var + EPS)).reshape(B, T, H * DV)
    return y * w.astype(F32)


def _causal_dwconv(u, buf, w, b):
    full = jnp.concatenate([buf.astype(u.dtype), u], axis=1)
    y = lax.conv_general_dilated(
        full, w.astype(u.dtype)[:, None, :], window_strides=(1,), padding='VALID',
        dimension_numbers=('NWC', 'WIO', 'NWC'), feature_group_count=u.shape[-1])
    return y + b.astype(u.dtype), full[:, -(CONV_K - 1):]


def _mem_kv(mem, mem_norm_w, w_mem_kv):
    B = mem.shape[0]
    kv = _rmsnorm(mem, mem_norm_w) @ w_mem_kv
    k, v = jnp.split(kv, 2, axis=-1)
    return (k.reshape(B, -1, MEM_HEADS, MEM_DH), v.reshape(B, -1, MEM_HEADS, MEM_DH))


def _mem_attend(q, k, v):
    B, T, _ = q.shape
    qh = q.reshape(B, T, MEM_HEADS, MEM_DH).astype(F32)
    s = jnp.einsum('bthd,bmhd->bhtm', qh, k.astype(F32)) * (MEM_DH ** -0.5)
    p = jax.nn.softmax(s, axis=-1)
    o = jnp.einsum('bhtm,bmhd->bthd', p, v.astype(F32))
    return o.reshape(B, T, MEM_W).astype(q.dtype)


def _layer(x, pos0, s0, conv_buf, mem_k, mem_v, norm_w, w_in, ret_gn_w, conv_w, conv_b,
           conv_ln_w, conv_ln_b, w_br_ret, w_br_conv, w_br_mem, w_out):
    B, T, _ = x.shape
    h = _rmsnorm(x, norm_w)
    z = h @ w_in
    sizes = (RET_W, RET_W, RET_VW, RET_VW, CONV_W, CONV_W, CONV_W, MEM_W, MEM_W)
    offs = np.cumsum(sizes).tolist()
    q_r, k_r, v_r, g_r, a_c, b_c, g_c, q_m, g_m, g_merge = jnp.split(z, offs, axis=-1)

    pos = jnp.arange(T, dtype=F32) + pos0
    q = _rotary(q_r.reshape(B, T, RET_HEADS, RET_DK).astype(F32), pos) * (RET_DK ** -0.5)
    k = _rotary(k_r.reshape(B, T, RET_HEADS, RET_DK).astype(F32), pos)
    v = v_r.reshape(B, T, RET_HEADS, RET_DV).astype(F32)
    o, s_new = _retention(q, k, v, s0)
    ret = _group_norm_heads(o, ret_gn_w).astype(x.dtype)
    br_r = (jax.nn.silu(g_r) * ret) @ w_br_ret

    u = a_c * jax.nn.sigmoid(b_c)
    c, buf_new = _causal_dwconv(u, conv_buf, conv_w, conv_b)
    c = jax.nn.silu(_layernorm(c, conv_ln_w, conv_ln_b))
    br_c = (jax.nn.silu(g_c) * c) @ w_br_conv

    m = _mem_attend(q_m, mem_k, mem_v)
    br_m = (jax.nn.silu(g_m) * m) @ w_br_mem

    g = jax.nn.sigmoid(g_merge).reshape(B, T, N_BRANCH, D_MODEL)
    merged = g[:, :, 0] * br_r + g[:, :, 1] * br_c + g[:, :, 2] * br_m
    return x + merged @ w_out, s_new, buf_new


def setup_inputs(seed: int = 0) -> dict:
    key = jax.random.key(seed)
    ks = jax.random.split(key, 21)

    def nrm(k, shape, s):
        return s * jax.random.normal(k, shape, F32)

    return {
        'x_prompt': nrm(ks[0], (BATCH, SEQ, D_MODEL), 1.0),
        'x_sample': nrm(ks[1], (DEC_BATCH, DEC_SEQ, D_MODEL), 1.0),
        'mem_prompt': nrm(ks[2], (BATCH, N_MEM, D_MODEL), 1.0),
        'state_ret': nrm(ks[3], (DEPTH, DEC_BATCH, RET_HEADS, RET_DK, RET_DV), 4.0),
        'state_conv': nrm(ks[4], (DEPTH, DEC_BATCH, CONV_K - 1, CONV_W), 0.5),
        'cache_mem_k': nrm(ks[5], (DEPTH, DEC_BATCH, N_MEM, MEM_HEADS, MEM_DH), 1.0),
        'cache_mem_v': nrm(ks[6], (DEPTH, DEC_BATCH, N_MEM, MEM_HEADS, MEM_DH), 1.0),
        'norm_w': 1.0 + nrm(ks[7], (DEPTH, D_MODEL), 0.02),
        'w_in': nrm(ks[8], (DEPTH, D_MODEL, IN_W), D_MODEL ** -0.5),
        'ret_gn_w': 1.0 + nrm(ks[9], (DEPTH, RET_VW), 0.02),
        'conv_w': nrm(ks[10], (DEPTH, CONV_K, CONV_W), CONV_K ** -0.5),
        'conv_b': nrm(ks[11], (DEPTH, CONV_W), 0.02),
        'conv_ln_w': 1.0 + nrm(ks[12], (DEPTH, CONV_W), 0.02),
        'conv_ln_b': nrm(ks[13], (DEPTH, CONV_W), 0.02),
        'mem_norm_w': 1.0 + nrm(ks[14], (DEPTH, D_MODEL), 0.02),
        'w_mem_kv': nrm(ks[15], (DEPTH, D_MODEL, 2 * MEM_W), D_MODEL ** -0.5),
        'w_br_ret': nrm(ks[16], (DEPTH, RET_VW, D_MODEL), RET_VW ** -0.5),
        'w_br_conv': nrm(ks[17], (DEPTH, CONV_W, D_MODEL), CONV_W ** -0.5),
        'w_br_mem': nrm(ks[18], (DEPTH, MEM_W, D_MODEL), MEM_W ** -0.5),
        'w_out': nrm(ks[19], (DEPTH, D_MODEL, D_MODEL), D_MODEL ** -0.5),
        'final_norm_w': 1.0 + nrm(ks[20], (D_MODEL,), 0.02),
    }


def reference(x_prompt, x_sample, mem_prompt, state_ret, state_conv, cache_mem_k, cache_mem_v,
              norm_w, w_in, ret_gn_w, conv_w, conv_b, conv_ln_w, conv_ln_b, mem_norm_w,
              w_mem_kv, w_br_ret, w_br_conv, w_br_mem, w_out, final_norm_w):
    hp, hs = x_prompt, x_sample
    bp = x_prompt.shape[0]
    ret_p, ret_s, conv_p, conv_s, mk_p, mv_p = [], [], [], [], [], []
    for l in range(DEPTH):
        lw = (norm_w[l], w_in[l], ret_gn_w[l], conv_w[l], conv_b[l], conv_ln_w[l],
              conv_ln_b[l], w_br_ret[l], w_br_conv[l], w_br_mem[l], w_out[l])
        mk, mv = _mem_kv(mem_prompt, mem_norm_w[l], w_mem_kv[l])
        s0 = jnp.zeros((bp, RET_HEADS, RET_DK, RET_DV), F32)
        buf0 = jnp.zeros((bp, CONV_K - 1, CONV_W), hp.dtype)
        hp, sp, cp = _layer(hp, 0, s0, buf0, mk, mv, *lw)
        hs, ss, cs = _layer(hs, PAST_LEN, state_ret[l], state_conv[l],
                            cache_mem_k[l], cache_mem_v[l], *lw)
        ret_p.append(sp)
        ret_s.append(ss)
        conv_p.append(cp)
        conv_s.append(cs)
        mk_p.append(mk)
        mv_p.append(mv)
    y_prompt = _rmsnorm(hp, final_norm_w)
    y_sample = _rmsnorm(hs, final_norm_w)
    return (y_prompt, y_sample, jnp.stack(ret_p), jnp.stack(ret_s), jnp.stack(conv_p),
            jnp.stack(conv_s), jnp.stack(mk_p), jnp.stack(mv_p))
```

```cpp
#include <hip/hip_runtime.h>
#include <hip/hip_cooperative_groups.h>
#include <cstdio>
#include <cstdint>
namespace cg = cooperative_groups;

#define LAS __attribute__((address_space(3)))
typedef unsigned short bf16_t;
typedef short bf16x8 __attribute__((ext_vector_type(8)));
typedef float f32x4 __attribute__((ext_vector_type(4)));
typedef float f32x2 __attribute__((ext_vector_type(2)));
typedef unsigned u32x4 __attribute__((ext_vector_type(4)));
typedef unsigned u32x2 __attribute__((ext_vector_type(2)));

constexpr int DM = 1024, TP = 2048, MP = 16384, BS = 128, NMEM = 256, INW = 7680;
constexpr int MZ = 16640;
constexpr int MXN = MZ + 2048;
constexpr int ZQ = 0, ZK = 512, ZV = 1024, ZGR = 1536, ZA = 2048, ZB = 2560, ZGC = 3072, ZQM = 3584, ZGM = 4096, ZG0 = 4608, ZG2 = 6656;
constexpr float EPS = 1e-6f;
constexpr size_t MiB = 1u << 20;
constexpr size_t WS_SS = 0;
constexpr size_t WS_COS = 1 * MiB, WS_SIN = 2 * MiB;
constexpr size_t WS_WT1 = 3 * MiB;
constexpr size_t WS_WTBR = 20 * MiB;
constexpr size_t WS_WTOUT = 23 * MiB;
constexpr size_t WS_KB = 25 * MiB;
constexpr size_t WS_VTG = 27 * MiB;
constexpr size_t WS_Z = 30 * MiB;
constexpr size_t WS_END = WS_Z + (size_t)MZ * INW * 2;
constexpr size_t O_YP = 0, O_YS = 16777216, O_RETP = 16908288, O_RETS = 17432576, O_CONVP = 25821184, O_CONVS = 25944064, O_MK = 27910144, O_MV = 28958720;
constexpr int LDS_BYTES = 147456;

struct Params { const float* in[21]; float* out; unsigned char* ws; };

__device__ __forceinline__ float bf2f(unsigned h) { return __uint_as_float(h << 16); }
__device__ __forceinline__ unsigned cvt_pk_bf16(float lo, float hi) { unsigned r; asm volatile("v_cvt_pk_bf16_f32 %0, %1, %2" : "=v"(r) : "v"(lo), "v"(hi)); return r; }
__device__ __forceinline__ unsigned short f2bf(float f) { return (unsigned short)(cvt_pk_bf16(f, 0.f) & 0xffffu); }
__device__ __forceinline__ void unpack8(const u32x4 w, float (&f)[8]) {
    f[0] = __uint_as_float(w.x << 16); f[1] = __uint_as_float(w.x & 0xffff0000u); f[2] = __uint_as_float(w.y << 16); f[3] = __uint_as_float(w.y & 0xffff0000u);
    f[4] = __uint_as_float(w.z << 16); f[5] = __uint_as_float(w.z & 0xffff0000u); f[6] = __uint_as_float(w.w << 16); f[7] = __uint_as_float(w.w & 0xffff0000u);
}
__device__ __forceinline__ u32x4 pack8(const float (&f)[8]) { u32x4 w; w.x = cvt_pk_bf16(f[0], f[1]); w.y = cvt_pk_bf16(f[2], f[3]); w.z = cvt_pk_bf16(f[4], f[5]); w.w = cvt_pk_bf16(f[6], f[7]); return w; }
__device__ __forceinline__ float sigmoidf_(float x) { return 1.0f / (1.0f + __expf(-x)); }
__device__ __forceinline__ float siluf_(float x) { return x / (1.0f + __expf(-x)); }
__device__ __forceinline__ float wave_sum(float v) {
#pragma unroll
    for (int o = 1; o < 64; o <<= 1) v += __shfl_xor(v, o);
    return v;
}
__device__ __forceinline__ float wave_max(float v) {
#pragma unroll
    for (int o = 1; o < 64; o <<= 1) v = fmaxf(v, __shfl_xor(v, o));
    return v;
}
__device__ __forceinline__ float sum16(float v) { v += __shfl_xor(v, 1); v += __shfl_xor(v, 2); v += __shfl_xor(v, 4); v += __shfl_xor(v, 8); return v; }
__device__ __forceinline__ float max16(float v) { v = fmaxf(v, __shfl_xor(v, 1)); v = fmaxf(v, __shfl_xor(v, 2)); v = fmaxf(v, __shfl_xor(v, 4)); v = fmaxf(v, __shfl_xor(v, 8)); return v; }
#define WAVE_LDS_SYNC() asm volatile("s_waitcnt lgkmcnt(0)" ::: "memory")
#define MFMA16(a, b, c) __builtin_amdgcn_mfma_f32_16x16x32_bf16((a), (b), (c), 0, 0, 0)

namespace pg8 {
constexpr int BM = 256, BK = 64, HALF = 128, HTB = HALF * BK * 2, STAGE_BYTES = 8 * HTB, NXCD = 8, WGM = 8;
__host__ __device__ __forceinline__ int lds_byte(int r, int c) { const int st = (r >> 4) * 2 + (c >> 5), rr = r & 15, cc = c & 31, ob = rr * 64 + cc * 2; return st * 1024 + (ob ^ (((ob >> 9) & 1) << 5)); }
__host__ __device__ __forceinline__ void stage_rc(int b, int& R, int& C) { const int st = b / 1024, sb = b % 1024, swz = sb ^ (((sb >> 9) & 1) << 5); R = (st >> 1) * 16 + swz / 64; C = (st & 1) * 32 + (swz % 64) / 2; }
__host__ __device__ __forceinline__ int perm32(int rho) { const int n = rho >> 4, i = rho & 15; return 8 * (i >> 2) + 4 * n + (i & 3); }

struct Unit { int pm, pn, kind; const char* a; const char* b; };
struct Gemm { int K, lda, ldb; };

template <class Epi, class Sched, bool ALIGN_EPI>
__device__ __forceinline__ void gemm_phase(LAS unsigned char* lds, const Gemm g, const Sched& S, const Epi& E) {
    const int tid = threadIdx.x, wid = __builtin_amdgcn_readfirstlane(tid >> 6), lane = tid & 63, wr = wid >> 2, wc = wid & 3, fr = lane & 15, fq = lane >> 4;
    const int K = g.K, nt = K / BK;
    unsigned voffA[2], voffB[2];
#pragma unroll
    for (int i = 0; i < 2; ++i) { int R, C; stage_rc(tid * 16 + i * 8192, R, C); const int Rb = Epi::PERM ? ((R & ~31) + perm32(R & 31)) : R;
        voffA[i] = (unsigned)(R * g.lda + C) * 2u; voffB[i] = (unsigned)(Rb * g.ldb + C) * 2u; }
    const size_t kstep = (size_t)(BK * 2);
    const size_t hstepA = (size_t)HALF * g.lda * 2, hstepB = (size_t)HALF * g.ldb * 2;
    const unsigned ldsw = (unsigned)wid * 1024u;
    const int aoff = lds_byte(wr * 64 + fr, fq * 8), boff = lds_byte(wc * 32 + fr, fq * 8);
#define PG8_SA(b, h) (((b) * 2 + (h)) * HTB)
#define PG8_SB(b, h) ((4 + (b) * 2 + (h)) * HTB)
#define PG8_STAGE(bufoff, gbase, voff) do { _Pragma("unroll") for (int _i = 0; _i < 2; ++_i) \
        __builtin_amdgcn_global_load_lds((const unsigned*)((const char*)(gbase) + (voff)[_i]), (LAS unsigned*)(lds + (bufoff) + ldsw + _i * 8192), 16, 0, 0); } while (0)
#define PG8_LDA(dst, b, h) do { _Pragma("unroll") for (int m = 0; m < 4; ++m) _Pragma("unroll") for (int k = 0; k < 2; ++k) dst[m][k] = *(const LAS bf16x8*)(lds + PG8_SA(b, h) + aoff + m * 2048 + k * 1024); } while (0)
#define PG8_LDB(dst, b, h) do { _Pragma("unroll") for (int n = 0; n < 2; ++n) _Pragma("unroll") for (int k = 0; k < 2; ++k) dst[n][k] = *(const LAS bf16x8*)(lds + PG8_SB(b, h) + boff + n * 2048 + k * 1024); } while (0)
#define PG8_MMA(ai, bj, At, Bt) do { __builtin_amdgcn_s_setprio(1); _Pragma("unroll") for (int m = 0; m < 4; ++m) _Pragma("unroll") for (int n = 0; n < 2; ++n) _Pragma("unroll") for (int k = 0; k < 2; ++k) \
        acc[ai][bj][m][n] = __builtin_amdgcn_mfma_f32_16x16x32_bf16(Bt[n][k], At[m][k], acc[ai][bj][m][n], 0, 0, 0); __builtin_amdgcn_s_setprio(0); } while (0)
#define PG8_WAIT_V(n) asm volatile("s_waitcnt vmcnt(" #n ")" ::: "memory")
#define PG8_WAIT_L(n) asm volatile("s_waitcnt lgkmcnt(" #n ")" ::: "memory")
#define PG8_BAR __builtin_amdgcn_s_barrier()
#define PG8_SCHED __builtin_amdgcn_sched_barrier(0)
    Unit cur, nxt; int ui = 0;
    if (!S.next(0, cur)) return;
    f32x4 acc[2][2][4][2];
#pragma unroll
    for (int a = 0; a < 2; ++a)
#pragma unroll
        for (int b = 0; b < 2; ++b)
#pragma unroll
            for (int m = 0; m < 4; ++m)
#pragma unroll
                for (int n = 0; n < 2; ++n) acc[a][b][m][n] = (f32x4){0.f, 0.f, 0.f, 0.f};
    bf16x8 At[4][2], B0[2][2], B1[2][2];
    const char* cA = cur.a; const char* cB = cur.b;
    PG8_STAGE(PG8_SB(0, 0), cB, voffB); PG8_STAGE(PG8_SB(0, 1), cB + hstepB, voffB); PG8_STAGE(PG8_SA(0, 0), cA, voffA); PG8_STAGE(PG8_SA(0, 1), cA + hstepA, voffA);
    if (wr == 1) PG8_BAR;
    PG8_WAIT_V(2); PG8_BAR;
    PG8_STAGE(PG8_SB(1, 0), cB + kstep, voffB); PG8_STAGE(PG8_SA(1, 0), cA + kstep, voffA); PG8_STAGE(PG8_SB(1, 1), cB + hstepB + kstep, voffB);
    PG8_WAIT_V(6); PG8_BAR;
    for (;;) {
        const bool has_next = S.next(ui + 1, nxt);
        const char* nA = has_next ? nxt.a : cA; const char* nB = has_next ? nxt.b : cB;
        for (int t = 0; t < nt; t += 2) {
            const bool last = (t == nt - 2);
            const char* a1 = cA + (size_t)(t + 1) * kstep;
            const char* a2 = last ? nA : cA + (size_t)(t + 2) * kstep; const char* b2 = last ? nB : cB + (size_t)(t + 2) * kstep;
            const char* a3 = a2 + kstep; const char* b3 = b2 + kstep;
            PG8_LDB(B0, 0, 0); PG8_LDB(B1, 0, 1); PG8_SCHED; PG8_LDA(At, 0, 0); PG8_STAGE(PG8_SA(1, 1), a1 + hstepA, voffA);
            PG8_WAIT_V(8); PG8_WAIT_L(0); PG8_BAR; PG8_MMA(0, 0, At, B0); PG8_MMA(0, 1, At, B1); PG8_BAR; PG8_SCHED;
            PG8_LDA(At, 0, 1); PG8_STAGE(PG8_SB(0, 0), b2, voffB); PG8_STAGE(PG8_SB(0, 1), b2 + hstepB, voffB); PG8_STAGE(PG8_SA(0, 0), a2, voffA);
            PG8_WAIT_V(8); PG8_WAIT_L(0); PG8_BAR; PG8_MMA(1, 0, At, B0); PG8_MMA(1, 1, At, B1); PG8_BAR; PG8_SCHED;
            PG8_LDB(B0, 1, 0); PG8_LDB(B1, 1, 1); PG8_SCHED; PG8_LDA(At, 1, 0); PG8_STAGE(PG8_SA(0, 1), a2 + hstepA, voffA);
            PG8_WAIT_V(8); PG8_WAIT_L(0); PG8_BAR; PG8_MMA(0, 0, At, B0); PG8_MMA(0, 1, At, B1); PG8_BAR; PG8_SCHED;
            PG8_LDA(At, 1, 1); PG8_STAGE(PG8_SB(1, 0), b3, voffB); PG8_STAGE(PG8_SB(1, 1), b3 + hstepB, voffB); PG8_STAGE(PG8_SA(1, 0), a3, voffA);
            PG8_WAIT_V(8); PG8_WAIT_L(0); PG8_BAR; PG8_MMA(1, 0, At, B0); PG8_MMA(1, 1, At, B1); PG8_BAR; PG8_SCHED;
        }
        if constexpr (ALIGN_EPI) { if (wr == 0) PG8_BAR; }
        E(acc, cur, wr, wc, fr, fq);
        if (!has_next) break;
#pragma unroll
        for (int a = 0; a < 2; ++a)
#pragma unroll
            for (int b = 0; b < 2; ++b)
#pragma unroll
                for (int m = 0; m < 4; ++m)
#pragma unroll
                    for (int n = 0; n < 2; ++n) acc[a][b][m][n] = (f32x4){0.f, 0.f, 0.f, 0.f};
        cur = nxt; cA = nA; cB = nB; ++ui;
        if constexpr (ALIGN_EPI) { if (wr == 1) PG8_BAR; }
    }
    PG8_WAIT_V(0);
    if constexpr (!ALIGN_EPI) { if (wr == 0) PG8_BAR; }
    PG8_BAR;
#undef PG8_SA
#undef PG8_SB
#undef PG8_STAGE
#undef PG8_LDA
#undef PG8_LDB
#undef PG8_MMA
#undef PG8_WAIT_V
#undef PG8_WAIT_L
#undef PG8_BAR
#undef PG8_SCHED
}
}
using pg8::Unit;

struct SchedZ {
    int G, c; const char* A; const char* B;
    __device__ bool next(int i, Unit& u) const {
        const int L = i * G + c; constexpr int nM = 65, nN = 30, nwg = nM * nN;
        if (L >= nwg + 32) return false;
        if (L < nwg) {
            int wgid = L; { const int q = nwg / 8, r = nwg % 8, xcd = wgid % 8, off = wgid / 8; wgid = (xcd < r ? xcd * (q + 1) : r * (q + 1) + (xcd - r) * q) + off; }
            const int nig = 8 * nN, gid = wgid / nig, fm = gid * 8, gsz = (nM - fm) < 8 ? (nM - fm) : 8;
            u.pm = fm + ((wgid % nig) % gsz); u.pn = (wgid % nig) / gsz; u.kind = 0;
        } else { const int Lm = L - nwg; u.pm = 65 + (Lm >> 2); u.pn = 30 + (Lm & 3); u.kind = 1; }
        u.a = A + (size_t)u.pm * 256 * DM * 2; u.b = B + (size_t)u.pn * 256 * DM * 2; return true;
    }
};
struct SchedBr {
    int G, c; const char* Z; const char* W;
    __device__ bool next(int i, Unit& u) const {
        const int tri = (i / 3) * G + c, br = i % 3; if (tri >= 256) return false;
        u.pm = tri >> 2; u.pn = tri & 3; u.kind = br;
        const int acol = br == 0 ? ZQ : (br == 1 ? ZGC : ZQM);
        u.a = Z + ((size_t)u.pm * 256 * INW + acol) * 2; u.b = W + ((size_t)(br * 1024 + u.pn * 256) * 512) * 2; return true;
    }
};
struct SchedOut {
    int G, c; const char* Z; const char* W;
    __device__ bool next(int i, Unit& u) const {
        const int L = i * G + c; if (L >= 256) return false;
        u.pm = L >> 2; u.pn = L & 3; u.kind = 0;
        u.a = Z + ((size_t)u.pm * 256 * INW + ZG2) * 2; u.b = W + ((size_t)(u.pn * 256) * DM) * 2; return true;
    }
};

struct EpiZ {
    static constexpr bool PERM = true;
    bf16_t* Z; float* mk; float* mv; bf16_t* KB; bf16_t* VTG;
    __device__ __forceinline__ void operator()(const f32x4 (&acc)[2][2][4][2], const Unit& u, int wr, int wc, int fr, int fq) const {
        if (u.kind == 0) {
            const int row0 = u.pm * 256 + wr * 64 + fr, col0 = u.pn * 256 + wc * 32 + 8 * fq;
#pragma unroll
            for (int ai = 0; ai < 2; ++ai)
#pragma unroll
                for (int m = 0; m < 4; ++m) { bf16_t* rowp = Z + (size_t)(row0 + ai * 128 + m * 16) * INW + col0;
#pragma unroll
                    for (int bj = 0; bj < 2; ++bj) { const f32x4 v0 = acc[ai][bj][m][0], v1 = acc[ai][bj][m][1];
                        u32x4 w; w.x = cvt_pk_bf16(v0[0], v0[1]); w.y = cvt_pk_bf16(v0[2], v0[3]); w.z = cvt_pk_bf16(v1[0], v1[1]); w.w = cvt_pk_bf16(v1[2], v1[3]);
                        *(u32x4*)(rowp + bj * 128) = w; } }
        } else {
            const int mrow0 = (u.pm - 65) * 256 + wr * 64 + fr, col0 = (u.pn - 30) * 256 + wc * 32 + 8 * fq;
#pragma unroll
            for (int ai = 0; ai < 2; ++ai)
#pragma unroll
                for (int m = 0; m < 4; ++m) { const int mrow = mrow0 + ai * 128 + m * 16;
#pragma unroll
                    for (int bj = 0; bj < 2; ++bj) { const int cc = col0 + bj * 128; const f32x4 v0 = acc[ai][bj][m][0], v1 = acc[ai][bj][m][1];
                        if (cc < 512) {
                            *(f32x4*)(mk + (size_t)mrow * 512 + cc) = v0; *(f32x4*)(mk + (size_t)mrow * 512 + cc + 4) = v1;
                            u32x4 w; w.x = cvt_pk_bf16(v0[0], v0[1]); w.y = cvt_pk_bf16(v0[2], v0[3]); w.z = cvt_pk_bf16(v1[0], v1[1]); w.w = cvt_pk_bf16(v1[2], v1[3]);
                            *(u32x4*)(KB + (size_t)mrow * 512 + cc) = w;
                        } else {
                            const int e0 = cc - 512; *(f32x4*)(mv + (size_t)mrow * 512 + e0) = v0; *(f32x4*)(mv + (size_t)mrow * 512 + e0 + 4) = v1;
                            const int b = mrow >> 8, mm = mrow & 255;
                            bf16_t* vp = VTG + ((size_t)(b * 512 + e0)) * 256 + mm;
#pragma unroll
                            for (int t = 0; t < 4; ++t) { vp[(size_t)t * 256] = f2bf(v0[t]); vp[(size_t)(t + 4) * 256] = f2bf(v1[t]); }
                        } } }
        }
    }
};
struct EpiBr {
    static constexpr bool PERM = true;
    bf16_t* Z;
    __device__ __forceinline__ void operator()(const f32x4 (&acc)[2][2][4][2], const Unit& u, int wr, int wc, int fr, int fq) const {
        const int br = u.kind; const int row0 = u.pm * 256 + wr * 64 + fr, col0 = u.pn * 256 + wc * 32 + 8 * fq;
#pragma unroll
        for (int ai = 0; ai < 2; ++ai)
#pragma unroll
            for (int m = 0; m < 4; ++m) { bf16_t* rowp = Z + (size_t)(row0 + ai * 128 + m * 16) * INW + ZG0 + br * 1024 + col0;
#pragma unroll
                for (int bj = 0; bj < 2; ++bj) { const f32x4 v0 = acc[ai][bj][m][0], v1 = acc[ai][bj][m][1];
                    float g[8]; unpack8(*(const u32x4*)(rowp + bj * 128), g);
                    float o[8];
#pragma unroll
                    for (int t = 0; t < 4; ++t) { o[t] = sigmoidf_(g[t]) * v0[t]; o[t + 4] = sigmoidf_(g[t + 4]) * v1[t]; }
                    if (br > 0) { float pv[8]; unpack8(*(const u32x4*)(rowp - 1024 + bj * 128), pv);
#pragma unroll
                        for (int t = 0; t < 8; ++t) o[t] += pv[t]; }
                    *(u32x4*)(rowp + bj * 128) = pack8(o); } }
    }
};
struct EpiOut {
    static constexpr bool PERM = false;
    const float* x; float* y; float* ss;
    __device__ __forceinline__ void operator()(const f32x4 (&acc)[2][2][4][2], const Unit& u, int wr, int wc, int fr, int fq) const {
#pragma unroll
        for (int ai = 0; ai < 2; ++ai)
#pragma unroll
            for (int m = 0; m < 4; ++m) { const int row = u.pm * 256 + ai * 128 + wr * 64 + m * 16 + fr; float q = 0.f;
#pragma unroll
                for (int bj = 0; bj < 2; ++bj)
#pragma unroll
                    for (int n = 0; n < 2; ++n) { const size_t off = (size_t)row * DM + u.pn * 256 + bj * 128 + wc * 32 + n * 16 + 4 * fq;
                        const f32x4 v = *(const f32x4*)(x + off) + acc[ai][bj][m][n]; *(f32x4*)(y + off) = v;
                        q += (v[0] * v[0] + v[1] * v[1]) + (v[2] * v[2] + v[3] * v[3]); }
                q += __shfl_xor(q, 16); q += __shfl_xor(q, 32);
                if (fq == 0) atomicAdd(ss + row, q); }
    }
};

__device__ __forceinline__ void p0_transpose_item(const float* W, int K, int N, bf16_t* WT, int row_off, LAS float* scr, int item, int lane) {
    const int nblk = N / 32, kb = item / nblk, nb = item % nblk, k0 = 64 * kb, n0 = 32 * nb;
#pragma unroll 8
    for (int i = 0; i < 32; ++i) { const int kk = 2 * i + (lane >> 5); scr[kk * 33 + (lane & 31)] = W[(size_t)(k0 + kk) * N + n0 + (lane & 31)]; }
    WAVE_LDS_SYNC();
    const int c = lane & 7;
#pragma unroll
    for (int j = 0; j < 4; ++j) { const int n = (lane >> 3) + 8 * j; const LAS float* s = scr + (8 * c) * 33 + n;
        u32x4 o; o.x = cvt_pk_bf16(s[0 * 33], s[1 * 33]); o.y = cvt_pk_bf16(s[2 * 33], s[3 * 33]); o.z = cvt_pk_bf16(s[4 * 33], s[5 * 33]); o.w = cvt_pk_bf16(s[6 * 33], s[7 * 33]);
        *(u32x4*)(WT + (size_t)(row_off + n0 + n) * K + k0 + 8 * c) = o; }
    WAVE_LDS_SYNC();
}
__device__ __forceinline__ void rms_row_to_bf16(const float* xrow, const float* w, bf16_t* orow, int lane) {
    const f32x4* xr = (const f32x4*)xrow + lane; const f32x4* wr = (const f32x4*)w + lane;
    f32x4 v[4]; float s = 0.f;
#pragma unroll
    for (int j = 0; j < 4; ++j) { v[j] = xr[64 * j]; s += (v[j][0] * v[j][0] + v[j][1] * v[j][1]) + (v[j][2] * v[j][2] + v[j][3] * v[j][3]); }
    const float rstd = rsqrtf(wave_sum(s) * (1.f / DM) + EPS);
    u32x2* o8 = (u32x2*)orow + lane;
#pragma unroll
    for (int j = 0; j < 4; ++j) { const f32x4 ww = wr[64 * j]; u32x2 o; o.x = cvt_pk_bf16(v[j][0] * rstd * ww[0], v[j][1] * rstd * ww[1]); o.y = cvt_pk_bf16(v[j][2] * rstd * ww[2], v[j][3] * rstd * ww[3]); o8[64 * j] = o; }
}

constexpr int RS = 136;

__device__ __forceinline__ void kv_task(const Params& p, LAS unsigned char* lds, int task, int tid, int lane, int wid) {
    const int n = task & 15, bh = task >> 4, h = bh & 3, b = bh >> 2;
    const bf16_t* Z = (const bf16_t*)(p.ws + WS_Z); const float* COS = (const float*)(p.ws + WS_COS); const float* SIN = (const float*)(p.ws + WS_SIN);
    float* KVT = p.out + O_YP;
    LAS bf16_t* Kt = (LAS bf16_t*)lds; LAS bf16_t* Vt = (LAS bf16_t*)(lds + 128 * RS * 2);
    const float lg = log1pf(-exp2f(-5.f - (float)h));
    const int j = (wid & 1) * 64 + lane, cg4 = wid >> 1;
    const bf16_t* zr = Z + (size_t)(b * TP + n * 128 + j) * INW + h * 128;
    const float kdec = expf((float)(127 - j) * lg);
    const int pos = n * 128 + j;
#pragma unroll
    for (int it = 0; it < 2; ++it) { const int d0 = (cg4 + 4 * it) * 8;
        float k1[8], k2[8]; unpack8(*(const u32x4*)(zr + ZK + d0), k1); unpack8(*(const u32x4*)(zr + ZK + 64 + d0), k2);
        const f32x4 c0 = *(const f32x4*)(COS + pos * 64 + d0), c1 = *(const f32x4*)(COS + pos * 64 + d0 + 4), s0 = *(const f32x4*)(SIN + pos * 64 + d0), s1 = *(const f32x4*)(SIN + pos * 64 + d0 + 4);
#pragma unroll
        for (int t = 0; t < 8; ++t) { const float cs = t < 4 ? c0[t & 3] : c1[t & 3], sn = t < 4 ? s0[t & 3] : s1[t & 3];
            Kt[(d0 + t) * RS + j] = f2bf((k1[t] * cs - k2[t] * sn) * kdec); Kt[(d0 + 64 + t) * RS + j] = f2bf((k1[t] * sn + k2[t] * cs) * kdec); } }
#pragma unroll
    for (int it = 0; it < 4; ++it) { const int e0 = (cg4 + 4 * it) * 8; const u32x4 w = *(const u32x4*)(zr + ZV + e0);
        Vt[(e0 + 0) * RS + j] = (bf16_t)(w.x & 0xffff); Vt[(e0 + 1) * RS + j] = (bf16_t)(w.x >> 16); Vt[(e0 + 2) * RS + j] = (bf16_t)(w.y & 0xffff); Vt[(e0 + 3) * RS + j] = (bf16_t)(w.y >> 16);
        Vt[(e0 + 4) * RS + j] = (bf16_t)(w.z & 0xffff); Vt[(e0 + 5) * RS + j] = (bf16_t)(w.z >> 16); Vt[(e0 + 6) * RS + j] = (bf16_t)(w.w & 0xffff); Vt[(e0 + 7) * RS + j] = (bf16_t)(w.w >> 16); }
    __syncthreads();
    const int r = lane & 15, q = lane >> 4;
    f32x4 acc[8];
#pragma unroll
    for (int nt = 0; nt < 8; ++nt) acc[nt] = (f32x4){0.f, 0.f, 0.f, 0.f};
#pragma unroll
    for (int ks = 0; ks < 4; ++ks) { const bf16x8 a = *(const LAS bf16x8*)(Vt + (16 * wid + r) * RS + 32 * ks + 8 * q);
#pragma unroll
        for (int nt = 0; nt < 8; ++nt) { const bf16x8 bb = *(const LAS bf16x8*)(Kt + (16 * nt + r) * RS + 32 * ks + 8 * q); acc[nt] = MFMA16(a, bb, acc[nt]); } }
    float* dst = KVT + (size_t)task * 16384;
#pragma unroll
    for (int nt = 0; nt < 8; ++nt)
#pragma unroll
        for (int i = 0; i < 4; ++i) dst[(16 * wid + 4 * q + i) * 128 + 16 * nt + r] = acc[nt][i];
    __syncthreads();
}

__device__ __forceinline__ void o_task(const Params& p, LAS unsigned char* lds, int task, int tid, int lane, int wid) {
    const int n = task & 15, bh = task >> 4, h = bh & 3, b = bh >> 2;
    bf16_t* Z = (bf16_t*)(p.ws + WS_Z); const float* COS = (const float*)(p.ws + WS_COS); const float* SIN = (const float*)(p.ws + WS_SIN);
    const float* KVT = p.out + O_YP; const float* gnw = p.in[9];
    LAS bf16_t* Qs = (LAS bf16_t*)lds; LAS bf16_t* Ks = (LAS bf16_t*)(lds + 128 * RS * 2); LAS bf16_t* Vt = (LAS bf16_t*)(lds + 2 * 128 * RS * 2);
    LAS bf16_t* Ps = (LAS bf16_t*)(lds + 3 * 128 * RS * 2 + wid * (16 * RS * 2));
    const float lg = log1pf(-exp2f(-5.f - (float)h));
    const size_t zrow0 = (size_t)b * TP + n * 128;
#pragma unroll
    for (int it = 0; it < 2; ++it) { const int item = tid + 512 * it, i = item >> 3, d0 = (item & 7) * 8;
        const bf16_t* zp = Z + (zrow0 + i) * INW + h * 128 + d0; const int pos = n * 128 + i;
        float q1[8], q2[8], k1[8], k2[8]; unpack8(*(const u32x4*)(zp + ZQ), q1); unpack8(*(const u32x4*)(zp + ZQ + 64), q2); unpack8(*(const u32x4*)(zp + ZK), k1); unpack8(*(const u32x4*)(zp + ZK + 64), k2);
        const f32x4 c0 = *(const f32x4*)(COS + pos * 64 + d0), c1 = *(const f32x4*)(COS + pos * 64 + d0 + 4), s0 = *(const f32x4*)(SIN + pos * 64 + d0), s1 = *(const f32x4*)(SIN + pos * 64 + d0 + 4);
        const float qsc = 0.08838834764831845f * expf((float)(i + 1) * lg), ksc = expf(-(float)(i + 1) * lg);
        float qa[8], qb[8], ka[8], kb[8];
#pragma unroll
        for (int t = 0; t < 8; ++t) { const float cs = t < 4 ? c0[t & 3] : c1[t & 3], sn = t < 4 ? s0[t & 3] : s1[t & 3];
            qa[t] = (q1[t] * cs - q2[t] * sn) * qsc; qb[t] = (q1[t] * sn + q2[t] * cs) * qsc; ka[t] = (k1[t] * cs - k2[t] * sn) * ksc; kb[t] = (k1[t] * sn + k2[t] * cs) * ksc; }
        *(LAS u32x4*)(Qs + i * RS + d0) = pack8(qa); *(LAS u32x4*)(Qs + i * RS + 64 + d0) = pack8(qb);
        *(LAS u32x4*)(Ks + i * RS + d0) = pack8(ka); *(LAS u32x4*)(Ks + i * RS + 64 + d0) = pack8(kb); }
    { const int j = (wid & 1) * 64 + lane, cg4 = wid >> 1; const bf16_t* zr = Z + (zrow0 + j) * INW + ZV + h * 128;
#pragma unroll
      for (int it = 0; it < 4; ++it) { const int e0 = (cg4 + 4 * it) * 8; const u32x4 w = *(const u32x4*)(zr + e0);
        Vt[(e0 + 0) * RS + j] = (bf16_t)(w.x & 0xffff); Vt[(e0 + 1) * RS + j] = (bf16_t)(w.x >> 16); Vt[(e0 + 2) * RS + j] = (bf16_t)(w.y & 0xffff); Vt[(e0 + 3) * RS + j] = (bf16_t)(w.y >> 16);
        Vt[(e0 + 4) * RS + j] = (bf16_t)(w.z & 0xffff); Vt[(e0 + 5) * RS + j] = (bf16_t)(w.z >> 16); Vt[(e0 + 6) * RS + j] = (bf16_t)(w.w & 0xffff); Vt[(e0 + 7) * RS + j] = (bf16_t)(w.w >> 16); } }
    __syncthreads();
    const int r = lane & 15, q = lane >> 4;
    f32x4 acc[8];
#pragma unroll
    for (int nt = 0; nt < 8; ++nt) acc[nt] = (f32x4){0.f, 0.f, 0.f, 0.f};
#pragma unroll
    for (int ks = 0; ks < 4; ++ks) { const bf16x8 a = *(const LAS bf16x8*)(Qs + (16 * wid + r) * RS + 32 * ks + 8 * q);
#pragma unroll
        for (int nt = 0; nt < 8; ++nt) { const bf16x8 bb = *(const LAS bf16x8*)(Ks + (16 * nt + r) * RS + 32 * ks + 8 * q); acc[nt] = MFMA16(a, bb, acc[nt]); } }
#pragma unroll
    for (int nt = 0; nt < 8; ++nt)
#pragma unroll
        for (int i = 0; i < 4; ++i) { const int ii = 16 * wid + 4 * q + i, jj = 16 * nt + r; Ps[(4 * q + i) * RS + jj] = f2bf(jj <= ii ? acc[nt][i] : 0.f); }
    __syncthreads();
    LAS bf16_t* St = Ks;
    { const float cdec = expf(128.f * lg);
#pragma unroll 1
      for (int it = 0; it < 8; ++it) { const int idx4 = tid + 512 * it, e = idx4 >> 5, d4 = (idx4 & 31) * 4;
        const float* kp = KVT + (size_t)(bh * 16) * 16384 + e * 128 + d4; f32x4 s = (f32x4){0.f, 0.f, 0.f, 0.f};
        for (int m = 0; m < n; ++m) { const f32x4 kv = *(const f32x4*)(kp + (size_t)m * 16384); s = s * cdec + kv; }
        u32x2 w; w.x = cvt_pk_bf16(s[0], s[1]); w.y = cvt_pk_bf16(s[2], s[3]); *(LAS u32x2*)(St + e * RS + d4) = w;
        if (n == 15) { const f32x4 kv = *(const f32x4*)(kp + (size_t)15 * 16384); const f32x4 fin = s * cdec + kv; float* rp = p.out + O_RETP + (size_t)bh * 16384 + e;
#pragma unroll
            for (int t = 0; t < 4; ++t) rp[(size_t)(d4 + t) * 128] = fin[t]; } } }
    __syncthreads();
#pragma unroll
    for (int nt = 0; nt < 8; ++nt) acc[nt] = (f32x4){0.f, 0.f, 0.f, 0.f};
#pragma unroll
    for (int ks = 0; ks < 4; ++ks) { const bf16x8 a = *(const LAS bf16x8*)(Ps + r * RS + 32 * ks + 8 * q);
#pragma unroll
        for (int nt = 0; nt < 8; ++nt) { const bf16x8 bb = *(const LAS bf16x8*)(Vt + (16 * nt + r) * RS + 32 * ks + 8 * q); acc[nt] = MFMA16(a, bb, acc[nt]); } }
#pragma unroll
    for (int ks = 0; ks < 4; ++ks) { const bf16x8 a = *(const LAS bf16x8*)(Qs + (16 * wid + r) * RS + 32 * ks + 8 * q);
#pragma unroll
        for (int nt = 0; nt < 8; ++nt) { const bf16x8 bb = *(const LAS bf16x8*)(St + (16 * nt + r) * RS + 32 * ks + 8 * q); acc[nt] = MFMA16(a, bb, acc[nt]); } }
    WAVE_LDS_SYNC();
#pragma unroll
    for (int i = 0; i < 4; ++i) { float s = 0.f;
#pragma unroll
        for (int nt = 0; nt < 8; ++nt) s += acc[nt][i];
        const float mean = sum16(s) * (1.f / 128.f); float v = 0.f;
#pragma unroll
        for (int nt = 0; nt < 8; ++nt) { const float d = acc[nt][i] - mean; v += d * d; }
        const float rstd = rsqrtf(sum16(v) * (1.f / 128.f) + EPS);
#pragma unroll
        for (int nt = 0; nt < 8; ++nt) Ps[(4 * q + i) * RS + 16 * nt + r] = f2bf((acc[nt][i] - mean) * rstd); }
    WAVE_LDS_SYNC();
#pragma unroll
    for (int it = 0; it < 4; ++it) { const int rowl = (lane >> 4) + 4 * it, e0 = (lane & 15) * 8;
        float nv[8], g[8]; unpack8(*(const LAS u32x4*)(Ps + rowl * RS + e0), nv);
        bf16_t* zp = Z + (zrow0 + 16 * wid + rowl) * INW + h * 128 + e0; unpack8(*(const u32x4*)(zp + ZGR), g);
        const f32x4 w0 = *(const f32x4*)(gnw + h * 128 + e0), w1 = *(const f32x4*)(gnw + h * 128 + e0 + 4);
        float o[8];
#pragma unroll
        for (int t = 0; t < 8; ++t) o[t] = nv[t] * (t < 4 ? w0[t & 3] : w1[t & 3]) * siluf_(g[t]);
        *(u32x4*)(zp + ZQ) = pack8(o); }
    __syncthreads();
}

__device__ __forceinline__ void conv_task(const Params& p, LAS unsigned char* lds, int task, int tid, int lane, int wid) {
    const int b = task >> 6, t0 = (task & 63) * 32;
    bf16_t* Z = (bf16_t*)(p.ws + WS_Z);
    LAS float* ut = (LAS float*)lds;
    for (int item = tid; item < 62 * 64; item += 512) { const int rr = item >> 6, c0 = (item & 63) * 8, t = t0 - 30 + rr;
        float u[8];
        if (t >= 0) { const bf16_t* zp = Z + (size_t)(b * TP + t) * INW + c0; float a[8], g[8]; unpack8(*(const u32x4*)(zp + ZA), a); unpack8(*(const u32x4*)(zp + ZB), g);
#pragma unroll
            for (int k = 0; k < 8; ++k) u[k] = a[k] * sigmoidf_(g[k]);
        } else {
#pragma unroll
            for (int k = 0; k < 8; ++k) u[k] = 0.f; }
        *(LAS f32x4*)(ut + rr * 512 + c0) = (f32x4){u[0], u[1], u[2], u[3]}; *(LAS f32x4*)(ut + rr * 512 + c0 + 4) = (f32x4){u[4], u[5], u[6], u[7]};
        if (t >= TP - 30) { float* cp = p.out + O_CONVP + ((size_t)b * 30 + (t - (TP - 30))) * 512 + c0; *(f32x4*)cp = (f32x4){u[0], u[1], u[2], u[3]}; *(f32x4*)(cp + 4) = (f32x4){u[4], u[5], u[6], u[7]}; } }
    __syncthreads();
    { const int c = tid; float w[31];
#pragma unroll
      for (int k = 0; k < 31; ++k) w[k] = p.in[10][k * 512 + c];
      const float bias = p.in[11][c];
#pragma unroll 1
      for (int g4 = 0; g4 < 8; ++g4) { float uu[34];
#pragma unroll
        for (int k = 0; k < 34; ++k) uu[k] = ut[(4 * g4 + k) * 512 + c];
        float y0 = bias, y1 = bias, y2 = bias, y3 = bias;
#pragma unroll
        for (int k = 0; k < 31; ++k) { y0 += w[k] * uu[k]; y1 += w[k] * uu[k + 1]; y2 += w[k] * uu[k + 2]; y3 += w[k] * uu[k + 3]; }
        ut[(4 * g4 + 0) * 512 + c] = y0; ut[(4 * g4 + 1) * 512 + c] = y1; ut[(4 * g4 + 2) * 512 + c] = y2; ut[(4 * g4 + 3) * 512 + c] = y3; } }
    __syncthreads();
    { const int c0 = lane * 8; const float* lw = p.in[12] + c0; const float* lb = p.in[13] + c0;
      const f32x4 w0 = *(const f32x4*)lw, w1 = *(const f32x4*)(lw + 4), b0 = *(const f32x4*)lb, b1 = *(const f32x4*)(lb + 4);
#pragma unroll 1
      for (int tt = wid; tt < 32; tt += 8) { const f32x4 x0 = *(const LAS f32x4*)(ut + tt * 512 + c0), x1 = *(const LAS f32x4*)(ut + tt * 512 + c0 + 4);
        const float mean = wave_sum((x0[0] + x0[1]) + (x0[2] + x0[3]) + (x1[0] + x1[1]) + (x1[2] + x1[3])) * (1.f / 512.f);
        const f32x4 d0 = x0 - mean, d1 = x1 - mean;
        const float rstd = rsqrtf(wave_sum((d0[0] * d0[0] + d0[1] * d0[1]) + (d0[2] * d0[2] + d0[3] * d0[3]) + (d1[0] * d1[0] + d1[1] * d1[1]) + (d1[2] * d1[2] + d1[3] * d1[3])) * (1.f / 512.f) + EPS);
        bf16_t* zp = Z + (size_t)(b * TP + t0 + tt) * INW + ZGC + c0; float g[8]; unpack8(*(const u32x4*)zp, g);
        float o[8];
#pragma unroll
        for (int t = 0; t < 8; ++t) { const float y = (t < 4 ? d0[t & 3] : d1[t & 3]) * rstd * (t < 4 ? w0[t & 3] : w1[t & 3]) + (t < 4 ? b0[t & 3] : b1[t & 3]); o[t] = siluf_(y) * siluf_(g[t]); }
        *(u32x4*)zp = pack8(o); } }
    __syncthreads();
}

__device__ __forceinline__ void attn_task(const Params& p, LAS unsigned char* lds, int task, int lane, int wid) {
    const int tile = task & 15, bh = task >> 4, h = bh & 3, b = bh >> 2;
    bf16_t* Z = (bf16_t*)(p.ws + WS_Z); const bf16_t* KB = (const bf16_t*)(p.ws + WS_KB); const bf16_t* VTG = (const bf16_t*)(p.ws + WS_VTG);
    constexpr int PS = 264;
    LAS bf16_t* Ps = (LAS bf16_t*)(lds + wid * (16 * PS * 2));
    const int r = lane & 15, q = lane >> 4;
    const size_t row0 = (size_t)b * TP + tile * 128 + 16 * wid;
    bf16x8 qf[4];
#pragma unroll
    for (int ks = 0; ks < 4; ++ks) qf[ks] = *(const bf16x8*)(Z + (row0 + r) * INW + ZQM + h * 128 + 32 * ks + 8 * q);
    f32x4 sc[16];
#pragma unroll
    for (int nt = 0; nt < 16; ++nt) { sc[nt] = (f32x4){0.f, 0.f, 0.f, 0.f}; const bf16_t* kp = KB + (size_t)(b * NMEM + 16 * nt + r) * 512 + h * 128 + 8 * q;
#pragma unroll
        for (int ks = 0; ks < 4; ++ks) { const bf16x8 bb = *(const bf16x8*)(kp + 32 * ks); sc[nt] = MFMA16(qf[ks], bb, sc[nt]); } }
    const float scale = 0.08838834764831845f;
    float inv[4];
#pragma unroll
    for (int i = 0; i < 4; ++i) { float mx = sc[0][i];
#pragma unroll
        for (int nt = 1; nt < 16; ++nt) mx = fmaxf(mx, sc[nt][i]);
        mx = max16(mx); float sum = 0.f;
#pragma unroll
        for (int nt = 0; nt < 16; ++nt) { const float e = __expf((sc[nt][i] - mx) * scale); sum += e; Ps[(4 * q + i) * PS + 16 * nt + r] = f2bf(e); }
        inv[i] = 1.0f / sum16(sum); }
    WAVE_LDS_SYNC();
    f32x4 o[8];
#pragma unroll
    for (int nt = 0; nt < 8; ++nt) o[nt] = (f32x4){0.f, 0.f, 0.f, 0.f};
#pragma unroll
    for (int ks = 0; ks < 8; ++ks) { const bf16x8 a = *(const LAS bf16x8*)(Ps + r * PS + 32 * ks + 8 * q);
#pragma unroll
        for (int nt = 0; nt < 8; ++nt) { const bf16x8 bb = *(const bf16x8*)(VTG + ((size_t)bh * 128 + 16 * nt + r) * 256 + 32 * ks + 8 * q); o[nt] = MFMA16(a, bb, o[nt]); } }
    WAVE_LDS_SYNC();
#pragma unroll
    for (int i = 0; i < 4; ++i)
#pragma unroll
        for (int nt = 0; nt < 8; ++nt) Ps[(4 * q + i) * PS + 16 * nt + r] = f2bf(o[nt][i] * inv[i]);
    WAVE_LDS_SYNC();
#pragma unroll
    for (int it = 0; it < 4; ++it) { const int rowl = (lane >> 4) + 4 * it, e0 = (lane & 15) * 8;
        float ov[8], g[8]; unpack8(*(const LAS u32x4*)(Ps + rowl * PS + e0), ov);
        bf16_t* zp = Z + (row0 + rowl) * INW + h * 128 + e0; unpack8(*(const u32x4*)(zp + ZGM), g);
        float oo[8];
#pragma unroll
        for (int t = 0; t < 8; ++t) oo[t] = ov[t] * siluf_(g[t]);
        *(u32x4*)(zp + ZQM) = pack8(oo); }
    WAVE_LDS_SYNC();
}

__device__ __forceinline__ void ret_sample_task(const Params& p, LAS float* wl, int task, int lane) {
    const int b = task >> 2, h = task & 3;
    bf16_t* zp = (bf16_t*)(p.ws + WS_Z) + (size_t)(MP + b) * INW + h * 128;
    const float* COS = (const float*)(p.ws + WS_COS); const float* SIN = (const float*)(p.ws + WS_SIN);
    const float q1 = bf2f(zp[ZQ + lane]), q2 = bf2f(zp[ZQ + 64 + lane]), k1 = bf2f(zp[ZK + lane]), k2 = bf2f(zp[ZK + 64 + lane]);
    const float cs = COS[2048 * 64 + lane], sn = SIN[2048 * 64 + lane];
    const float qa = (q1 * cs - q2 * sn) * 0.08838834764831845f, qb = (q1 * sn + q2 * cs) * 0.08838834764831845f, ka = k1 * cs - k2 * sn, kb = k1 * sn + k2 * cs;
    wl[lane] = qa; wl[64 + lane] = qb; wl[128 + lane] = ka; wl[192 + lane] = kb; wl[256 + lane] = bf2f(zp[ZV + lane]); wl[320 + lane] = bf2f(zp[ZV + 64 + lane]);
    const float qk = wave_sum(qa * ka + qb * kb);
    WAVE_LDS_SYNC();
    const float gamma = 1.0f - exp2f(-5.f - (float)h);
    const int e4 = (lane & 31) * 4, half = lane >> 5;
    const f32x4 vv = *(const LAS f32x4*)(wl + 256 + e4);
    f32x4 oacc = (f32x4){0.f, 0.f, 0.f, 0.f};
    const float* s0 = p.in[3] + (size_t)task * 16384 + e4; float* so = p.out + O_RETS + (size_t)task * 16384 + e4;
#pragma unroll 8
    for (int d2 = 0; d2 < 64; ++d2) { const int d = 2 * d2 + half; const f32x4 s = *(const f32x4*)(s0 + d * 128); const float qd = wl[d], kd = wl[128 + d];
        *(f32x4*)(so + d * 128) = s * gamma + vv * kd; oacc += s * qd; }
#pragma unroll
    for (int t = 0; t < 4; ++t) oacc[t] += __shfl_xor(oacc[t], 32);
    const f32x4 o = vv * qk + oacc * gamma;
    float s = (o[0] + o[1]) + (o[2] + o[3]);
#pragma unroll
    for (int k = 1; k < 32; k <<= 1) s += __shfl_xor(s, k);
    const float mean = s * (1.f / 128.f); const f32x4 d = o - mean; float v = (d[0] * d[0] + d[1] * d[1]) + (d[2] * d[2] + d[3] * d[3]);
#pragma unroll
    for (int k = 1; k < 32; k <<= 1) v += __shfl_xor(v, k);
    const float rstd = rsqrtf(v * (1.f / 128.f) + EPS);
    if (lane < 32) { const f32x4 gw = *(const f32x4*)(p.in[9] + h * 128 + e4); const u32x2 gr = *(const u32x2*)(zp + ZGR + e4);
        const float g0 = __uint_as_float(gr.x << 16), g1 = __uint_as_float(gr.x & 0xffff0000u), g2 = __uint_as_float(gr.y << 16), g3 = __uint_as_float(gr.y & 0xffff0000u);
        u32x2 w; w.x = cvt_pk_bf16(d[0] * rstd * gw[0] * siluf_(g0), d[1] * rstd * gw[1] * siluf_(g1)); w.y = cvt_pk_bf16(d[2] * rstd * gw[2] * siluf_(g2), d[3] * rstd * gw[3] * siluf_(g3));
        *(u32x2*)(zp + ZQ + e4) = w; }
    WAVE_LDS_SYNC();
}
__device__ __forceinline__ void conv_sample_task(const Params& p, int b, int lane) {
    bf16_t* zp = (bf16_t*)(p.ws + WS_Z) + (size_t)(MP + b) * INW; const int c0 = lane * 8;
    const float* sc = p.in[4] + (size_t)b * 30 * 512 + c0; float* so = p.out + O_CONVS + (size_t)b * 30 * 512 + c0; const float* cw = p.in[10] + c0;
    f32x4 y0 = *(const f32x4*)(p.in[11] + c0), y1 = *(const f32x4*)(p.in[11] + c0 + 4);
#pragma unroll 6
    for (int k = 0; k < 30; ++k) { const f32x4 f0 = *(const f32x4*)(sc + k * 512), f1 = *(const f32x4*)(sc + k * 512 + 4), w0 = *(const f32x4*)(cw + k * 512), w1 = *(const f32x4*)(cw + k * 512 + 4);
        y0 += w0 * f0; y1 += w1 * f1; if (k > 0) { *(f32x4*)(so + (k - 1) * 512) = f0; *(f32x4*)(so + (k - 1) * 512 + 4) = f1; } }
    { float a[8], g[8]; unpack8(*(const u32x4*)(zp + ZA + c0), a); unpack8(*(const u32x4*)(zp + ZB + c0), g);
      f32x4 u0, u1;
#pragma unroll
      for (int t = 0; t < 4; ++t) { u0[t] = a[t] * sigmoidf_(g[t]); u1[t] = a[t + 4] * sigmoidf_(g[t + 4]); }
      const f32x4 w0 = *(const f32x4*)(cw + 30 * 512), w1 = *(const f32x4*)(cw + 30 * 512 + 4); y0 += w0 * u0; y1 += w1 * u1;
      *(f32x4*)(so + 29 * 512) = u0; *(f32x4*)(so + 29 * 512 + 4) = u1; }
    const float mean = wave_sum((y0[0] + y0[1]) + (y0[2] + y0[3]) + (y1[0] + y1[1]) + (y1[2] + y1[3])) * (1.f / 512.f);
    const f32x4 d0 = y0 - mean, d1 = y1 - mean;
    const float rstd = rsqrtf(wave_sum((d0[0] * d0[0] + d0[1] * d0[1]) + (d0[2] * d0[2] + d0[3] * d0[3]) + (d1[0] * d1[0] + d1[1] * d1[1]) + (d1[2] * d1[2] + d1[3] * d1[3])) * (1.f / 512.f) + EPS);
    const f32x4 w0 = *(const f32x4*)(p.in[12] + c0), w1 = *(const f32x4*)(p.in[12] + c0 + 4), b0 = *(const f32x4*)(p.in[13] + c0), b1 = *(const f32x4*)(p.in[13] + c0 + 4);
    float g[8], o[8]; unpack8(*(const u32x4*)(zp + ZGC + c0), g);
#pragma unroll
    for (int t = 0; t < 8; ++t) { const float y = (t < 4 ? d0[t & 3] : d1[t & 3]) * rstd * (t < 4 ? w0[t & 3] : w1[t & 3]) + (t < 4 ? b0[t & 3] : b1[t & 3]); o[t] = siluf_(y) * siluf_(g[t]); }
    *(u32x4*)(zp + ZGC + c0) = pack8(o);
}
__device__ __forceinline__ void attn_sample_task(const Params& p, LAS float* wl, int task, int lane) {
    const int b = task >> 2, h = task & 3;
    bf16_t* zp = (bf16_t*)(p.ws + WS_Z) + (size_t)(MP + b) * INW + h * 128;
    const int sub = lane & 15, grp = lane >> 4;
    float qv[8]; unpack8(*(const u32x4*)(zp + ZQM + sub * 8), qv);
    const float* kbase = p.in[5] + ((size_t)b * NMEM * 4 + h) * 128 + sub * 8;
#pragma unroll 8
    for (int it = 0; it < 64; ++it) { const int m = 4 * it + grp; const float* kp = kbase + (size_t)m * 512; const f32x4 k0 = *(const f32x4*)kp, k1 = *(const f32x4*)(kp + 4);
        float d = (k0[0] * qv[0] + k0[1] * qv[1]) + (k0[2] * qv[2] + k0[3] * qv[3]) + (k1[0] * qv[4] + k1[1] * qv[5]) + (k1[2] * qv[6] + k1[3] * qv[7]);
        d = sum16(d); if (sub == 0) wl[m] = d * 0.08838834764831845f; }
    WAVE_LDS_SYNC();
    float s[4];
#pragma unroll
    for (int i = 0; i < 4; ++i) s[i] = wl[lane + 64 * i];
    const float mx = wave_max(fmaxf(fmaxf(s[0], s[1]), fmaxf(s[2], s[3])));
    float sum = 0.f;
#pragma unroll
    for (int i = 0; i < 4; ++i) { s[i] = __expf(s[i] - mx); sum += s[i]; }
    sum = wave_sum(sum);
    WAVE_LDS_SYNC();
#pragma unroll
    for (int i = 0; i < 4; ++i) wl[lane + 64 * i] = s[i];
    WAVE_LDS_SYNC();
    const int e4 = (lane & 31) * 4, half = lane >> 5;
    const float* vbase = p.in[6] + ((size_t)b * NMEM * 4 + h) * 128 + e4;
    f32x4 o = (f32x4){0.f, 0.f, 0.f, 0.f};
#pragma unroll 8
    for (int it = 0; it < 128; ++it) { const int m = 2 * it + half; const f32x4 v = *(const f32x4*)(vbase + (size_t)m * 512); o += v * wl[m]; }
#pragma unroll
    for (int t = 0; t < 4; ++t) o[t] += __shfl_xor(o[t], 32);
    const float is = 1.0f / sum;
    if (lane < 32) { const u32x2 gr = *(const u32x2*)(zp + ZGM + e4);
        const float g0 = __uint_as_float(gr.x << 16), g1 = __uint_as_float(gr.x & 0xffff0000u), g2 = __uint_as_float(gr.y << 16), g3 = __uint_as_float(gr.y & 0xffff0000u);
        u32x2 w; w.x = cvt_pk_bf16(o[0] * is * siluf_(g0), o[1] * is * siluf_(g1)); w.y = cvt_pk_bf16(o[2] * is * siluf_(g2), o[3] * is * siluf_(g3));
        *(u32x2*)(zp + ZQM + e4) = w; }
    WAVE_LDS_SYNC();
}
__device__ __forceinline__ void br_sample_tile(const Params& p, int tile, int lane) {
    const int rt = tile >> 6, ct = tile & 63, r = lane & 15, q = lane >> 4;
    bf16_t* Z = (bf16_t*)(p.ws + WS_Z); const bf16_t* W = (const bf16_t*)(p.ws + WS_WTBR);
    const bf16_t* arow = Z + (size_t)(MP + 16 * rt + r) * INW + 8 * q;
    float tot[4] = {0.f, 0.f, 0.f, 0.f};
#pragma unroll
    for (int br = 0; br < 3; ++br) { const int acol = br == 0 ? ZQ : (br == 1 ? ZGC : ZQM); const bf16_t* wrow = W + (size_t)(br * 1024 + 16 * ct + r) * 512 + 8 * q;
        f32x4 acc = (f32x4){0.f, 0.f, 0.f, 0.f};
#pragma unroll 4
        for (int ks = 0; ks < 16; ++ks) { const bf16x8 a = *(const bf16x8*)(arow + acol + 32 * ks), bb = *(const bf16x8*)(wrow + 32 * ks); acc = MFMA16(a, bb, acc); }
#pragma unroll
        for (int i = 0; i < 4; ++i) { const float g = bf2f(Z[(size_t)(MP + 16 * rt + 4 * q + i) * INW + ZG0 + br * 1024 + 16 * ct + r]); tot[i] += sigmoidf_(g) * acc[i]; } }
#pragma unroll
    for (int i = 0; i < 4; ++i) Z[(size_t)(MP + 16 * rt + 4 * q + i) * INW + ZG2 + 16 * ct + r] = f2bf(tot[i]);
}
__device__ __forceinline__ void out_sample_tile(const Params& p, int tile, int lane) {
    const int rt = tile >> 6, ct = tile & 63, r = lane & 15, q = lane >> 4;
    const bf16_t* Z = (const bf16_t*)(p.ws + WS_Z); const bf16_t* W = (const bf16_t*)(p.ws + WS_WTOUT);
    const bf16_t* arow = Z + (size_t)(MP + 16 * rt + r) * INW + ZG2 + 8 * q; const bf16_t* wrow = W + (size_t)(16 * ct + r) * DM + 8 * q;
    f32x4 acc = (f32x4){0.f, 0.f, 0.f, 0.f};
#pragma unroll 4
    for (int ks = 0; ks < 32; ++ks) { const bf16x8 a = *(const bf16x8*)(arow + 32 * ks), bb = *(const bf16x8*)(wrow + 32 * ks); acc = MFMA16(a, bb, acc); }
    float* ss = (float*)(p.ws + WS_SS) + MP;
#pragma unroll
    for (int i = 0; i < 4; ++i) { const int row = 16 * rt + 4 * q + i; const size_t off = (size_t)row * DM + 16 * ct + r; const float v = p.in[1][off] + acc[i]; p.out[O_YS + off] = v;
        const float s2 = sum16(v * v); if (r == 0) atomicAdd(ss + row, s2); }
}
__device__ __forceinline__ void final_norm_row(float* yrow, const float* fw, float ssv, int lane) {
    const float rstd = rsqrtf(ssv * (1.f / DM) + EPS); f32x4* yr = (f32x4*)yrow + lane; const f32x4* wr = (const f32x4*)fw + lane;
#pragma unroll
    for (int j = 0; j < 4; ++j) { const f32x4 v = yr[64 * j], w = wr[64 * j]; yr[64 * j] = v * rstd * w; }
}

__global__ void __launch_bounds__(512, 2) mega_fwd(Params p) {
    extern __shared__ __attribute__((aligned(16))) unsigned char lds_raw[];
    LAS unsigned char* lds = (LAS unsigned char*)lds_raw;
    cg::grid_group grid = cg::this_grid();
    const int tid = threadIdx.x, lane = tid & 63, wid = __builtin_amdgcn_readfirstlane(tid >> 6);
    const int G = gridDim.x, c = blockIdx.x;
    const int gw = c * 8 + wid, NGW = G * 8;
    unsigned char* ws = p.ws;
    bf16_t* XN = (bf16_t*)(p.out + O_YP);
    float* SS = (float*)(ws + WS_SS);

    {
        LAS float* scr = (LAS float*)(lds + wid * 16384);
        constexpr int I_IN = 16 * 240, I_KV = 16 * 32, I_BR = 8 * 32, I_OUT = 16 * 32, NIT = I_IN + I_KV + 3 * I_BR + I_OUT;
        for (int it = gw; it < NIT; it += NGW) {
            int r = it;
            if (r < I_IN) { p0_transpose_item(p.in[8], DM, INW, (bf16_t*)(ws + WS_WT1), 0, scr, r, lane); continue; } r -= I_IN;
            if (r < I_KV) { p0_transpose_item(p.in[15], DM, 1024, (bf16_t*)(ws + WS_WT1), INW, scr, r, lane); continue; } r -= I_KV;
            if (r < I_BR) { p0_transpose_item(p.in[16], 512, 1024, (bf16_t*)(ws + WS_WTBR), 0, scr, r, lane); continue; } r -= I_BR;
            if (r < I_BR) { p0_transpose_item(p.in[17], 512, 1024, (bf16_t*)(ws + WS_WTBR), 1024, scr, r, lane); continue; } r -= I_BR;
            if (r < I_BR) { p0_transpose_item(p.in[18], 512, 1024, (bf16_t*)(ws + WS_WTBR), 2048, scr, r, lane); continue; } r -= I_BR;
            p0_transpose_item(p.in[19], DM, 1024, (bf16_t*)(ws + WS_WTOUT), 0, scr, r, lane);
        }
        for (int m = gw; m < MXN; m += NGW) {
            bf16_t* orow = XN + (size_t)m * DM;
            if (m < MP) rms_row_to_bf16(p.in[0] + (size_t)m * DM, p.in[7], orow, lane);
            else if (m < MP + BS) rms_row_to_bf16(p.in[1] + (size_t)(m - MP) * DM, p.in[7], orow, lane);
            else if (m < MZ) { u32x2* o8 = (u32x2*)orow + lane;
#pragma unroll
                for (int j = 0; j < 4; ++j) o8[64 * j] = (u32x2){0u, 0u}; }
            else rms_row_to_bf16(p.in[2] + (size_t)(m - MZ) * DM, p.in[14], orow, lane);
        }
        float* COS = (float*)(ws + WS_COS); float* SIN = (float*)(ws + WS_SIN);
        for (int idx = c * 512 + tid; idx < 2049 * 64; idx += G * 512) { const int pp = idx >> 6, i = idx & 63; const double pos = pp < 2048 ? (double)pp : 16384.0;
            const double inv = exp2(-(double)i * (13.287712379549449 / 64.0));
            double rev = pos * inv * 0.15915494309189535; rev -= rint(rev);
            COS[idx] = __builtin_amdgcn_cosf((float)rev); SIN[idx] = __builtin_amdgcn_sinf((float)rev); }
        for (int idx = c * 512 + tid; idx < MP + BS; idx += G * 512) SS[idx] = 0.f;
    }
    grid.sync();

    {
        pg8::Gemm g{DM, DM, DM}; SchedZ S{G, c, (const char*)XN, (const char*)(ws + WS_WT1)};
        EpiZ E{(bf16_t*)(ws + WS_Z), p.out + O_MK, p.out + O_MV, (bf16_t*)(ws + WS_KB), (bf16_t*)(ws + WS_VTG)};
        pg8::gemm_phase<EpiZ, SchedZ, true>(lds, g, S, E);
    }
    grid.sync();

    {
        for (int t = c; t < 512; t += G) kv_task(p, lds, t, tid, lane, wid);
        for (int t = c; t < 512; t += G) conv_task(p, lds, t, tid, lane, wid);
        for (int t = c; t < 512; t += G) attn_task(p, lds, t, lane, wid);
        __syncthreads();
        LAS float* wl = (LAS float*)(lds + wid * 4096);
        for (int t = gw; t < 512; t += NGW) ret_sample_task(p, wl, t, lane);
        for (int t = gw; t < 512; t += NGW) attn_sample_task(p, wl, (t + 256) & 511, lane);
        for (int t = gw; t < 128; t += NGW) conv_sample_task(p, (t + 64) & 127, lane);
        __syncthreads();
    }
    grid.sync();

    {
        for (int t = c; t < 512; t += G) o_task(p, lds, t, tid, lane, wid);
        for (int t = gw; t < 512; t += NGW) br_sample_tile(p, t, lane);
    }
    grid.sync();

    {
        pg8::Gemm g{512, INW, 512}; SchedBr S{G, c, (const char*)(ws + WS_Z), (const char*)(ws + WS_WTBR)};
        EpiBr E{(bf16_t*)(ws + WS_Z)};
        pg8::gemm_phase<EpiBr, SchedBr, true>(lds, g, S, E);
        for (int t = gw; t < 512; t += NGW) out_sample_tile(p, t, lane);
    }
    grid.sync();

    {
        pg8::Gemm g{DM, INW, DM}; SchedOut S{G, c, (const char*)(ws + WS_Z), (const char*)(ws + WS_WTOUT)};
        EpiOut E{p.in[0], p.out + O_YP, SS};
        pg8::gemm_phase<EpiOut, SchedOut, false>(lds, g, S, E);
        for (int m = gw; m < BS; m += NGW) final_norm_row(p.out + O_YS + (size_t)m * DM, p.in[20], __hip_atomic_load(SS + MP + m, __ATOMIC_RELAXED, __HIP_MEMORY_SCOPE_AGENT), lane);
    }
    grid.sync();

    for (int m = gw; m < MP; m += NGW) final_norm_row(p.out + O_YP + (size_t)m * DM, p.in[20], __hip_atomic_load(SS + m, __ATOMIC_RELAXED, __HIP_MEMORY_SCOPE_AGENT), lane);
}

extern "C" void kernel_launch(void* const* d_in, const int* in_sizes, int n_in, void* d_out, int out_size, void* d_ws, size_t ws_size, hipStream_t stream) {
    static int grid = 0;
    if (grid == 0) {
        if (n_in != 21 || ws_size < WS_END) { fprintf(stderr, "kernel_launch: need 21 inputs and >= %zu bytes of workspace; got %d, %zu\n", (size_t)WS_END, n_in, ws_size); grid = -1; return; }
        int dev = 0, cus = 0, per_cu = 0;
        if (hipGetDevice(&dev) != hipSuccess || hipDeviceGetAttribute(&cus, hipDeviceAttributeMultiprocessorCount, dev) != hipSuccess) { grid = -1; return; }
        if (hipFuncSetAttribute((const void*)mega_fwd, hipFuncAttributeMaxDynamicSharedMemorySize, LDS_BYTES) != hipSuccess) { fprintf(stderr, "kernel_launch: hipFuncSetAttribute failed\n"); grid = -1; return; }
        if (hipOccupancyMaxActiveBlocksPerMultiprocessor(&per_cu, (const void*)mega_fwd, 512, LDS_BYTES) != hipSuccess || per_cu < 1) { fprintf(stderr, "kernel_launch: occupancy query reports %d blocks per CU\n", per_cu); grid = -1; return; }
        grid = cus;
    }
    if (grid < 0) return;
    Params p{};
    for (int i = 0; i < 21; ++i) p.in[i] = (const float*)d_in[i];
    p.out = (float*)d_out; p.ws = (unsigned char*)d_ws;
    void* args[] = {&p};
    hipError_t e = hipLaunchCooperativeKernel((const void*)mega_fwd, dim3(grid), dim3(512), args, LDS_BYTES, stream);
    if (e != hipSuccess) fprintf(stderr, "kernel_launch: cooperative launch failed: %s (grid %d)\n", hipGetErrorString(e), grid);
}
```

```cpp
#include <hip/hip_runtime.h>
#include <cstdio>
#include <cstdint>

#define LAS __attribute__((address_space(3)))
typedef unsigned short bf16_t;
typedef short bf16x8 __attribute__((ext_vector_type(8)));
typedef float f32x4 __attribute__((ext_vector_type(4)));
typedef float f32x2 __attribute__((ext_vector_type(2)));
typedef unsigned u32x4 __attribute__((ext_vector_type(4)));
typedef unsigned u32x2 __attribute__((ext_vector_type(2)));

constexpr int DM = 1024, TP = 2048, MP = 16384, BS = 128, NMEM = 256, INW = 7680;
constexpr int MZ = 16640;
constexpr int MXN = MZ + 2048;
constexpr int ZQ = 0, ZK = 512, ZV = 1024, ZGR = 1536, ZA = 2048, ZB = 2560, ZGC = 3072, ZQM = 3584, ZGM = 4096, ZG0 = 4608, ZG2 = 6656;
constexpr float EPS = 1e-6f;
constexpr size_t MiB = 1u << 20;
constexpr size_t WS_SS = 0;
constexpr size_t WS_BAR = 131072;
constexpr size_t WS_ZERO_BYTES = 131072 + 16384;
constexpr size_t WS_COS = 1 * MiB, WS_SIN = 2 * MiB;
constexpr size_t WS_WT1 = 3 * MiB;
constexpr size_t WS_WTBR = 20 * MiB;
constexpr size_t WS_WTOUT = 23 * MiB;
constexpr size_t WS_KB = 25 * MiB;
constexpr size_t WS_VTG = 27 * MiB;
constexpr size_t WS_Z = 30 * MiB;
constexpr size_t WS_END = WS_Z + (size_t)MZ * INW * 2;
constexpr size_t O_YP = 0, O_YS = 16777216, O_RETP = 16908288, O_RETS = 17432576, O_CONVP = 25821184, O_CONVS = 25944064, O_MK = 27910144, O_MV = 28958720;
constexpr int LDS_BYTES = 147456;

struct Params { const float* in[21]; float* out; unsigned char* ws; };

__device__ __forceinline__ float bf2f(unsigned h) { return __uint_as_float(h << 16); }
__device__ __forceinline__ unsigned cvt_pk_bf16(float lo, float hi) { unsigned r; asm volatile("v_cvt_pk_bf16_f32 %0, %1, %2" : "=v"(r) : "v"(lo), "v"(hi)); return r; }
__device__ __forceinline__ unsigned short f2bf(float f) { return (unsigned short)(cvt_pk_bf16(f, 0.f) & 0xffffu); }
__device__ __forceinline__ void unpack8(const u32x4 w, float (&f)[8]) {
    f[0] = __uint_as_float(w.x << 16); f[1] = __uint_as_float(w.x & 0xffff0000u); f[2] = __uint_as_float(w.y << 16); f[3] = __uint_as_float(w.y & 0xffff0000u);
    f[4] = __uint_as_float(w.z << 16); f[5] = __uint_as_float(w.z & 0xffff0000u); f[6] = __uint_as_float(w.w << 16); f[7] = __uint_as_float(w.w & 0xffff0000u);
}
__device__ __forceinline__ u32x4 pack8(const float (&f)[8]) { u32x4 w; w.x = cvt_pk_bf16(f[0], f[1]); w.y = cvt_pk_bf16(f[2], f[3]); w.z = cvt_pk_bf16(f[4], f[5]); w.w = cvt_pk_bf16(f[6], f[7]); return w; }
__device__ __forceinline__ float sigmoidf_(float x) { return 1.0f / (1.0f + __expf(-x)); }
__device__ __forceinline__ float siluf_(float x) { return x / (1.0f + __expf(-x)); }
__device__ __forceinline__ float wave_sum(float v) {
#pragma unroll
    for (int o = 1; o < 64; o <<= 1) v += __shfl_xor(v, o);
    return v;
}
__device__ __forceinline__ float wave_max(float v) {
#pragma unroll
    for (int o = 1; o < 64; o <<= 1) v = fmaxf(v, __shfl_xor(v, o));
    return v;
}
__device__ __forceinline__ float sum16(float v) { v += __shfl_xor(v, 1); v += __shfl_xor(v, 2); v += __shfl_xor(v, 4); v += __shfl_xor(v, 8); return v; }
__device__ __forceinline__ float max16(float v) { v = fmaxf(v, __shfl_xor(v, 1)); v = fmaxf(v, __shfl_xor(v, 2)); v = fmaxf(v, __shfl_xor(v, 4)); v = fmaxf(v, __shfl_xor(v, 8)); return v; }
#define WAVE_LDS_SYNC() asm volatile("s_waitcnt lgkmcnt(0)" ::: "memory")
#define MFMA16(a, b, c) __builtin_amdgcn_mfma_f32_16x16x32_bf16((a), (b), (c), 0, 0, 0)


#define XB_TMO      128
#define XB_XCNT(j)  (256  + 64 * (j))
#define XB_XSUB(j)  (1280 + 64 * (j))
#define XB_XGEN(j)  (2304 + 64 * (j))
#define XB_TOP      3328
#define XB_TOPGEN   3392
#define XCD_BAR_WORDS 3456
#define XB_SPIN_CAP (1u << 18)
__device__ __forceinline__ unsigned xb_ld(unsigned* p)              { return __hip_atomic_load(p, __ATOMIC_RELAXED, __HIP_MEMORY_SCOPE_AGENT); }
__device__ __forceinline__ unsigned xb_add(unsigned* p, unsigned v) { return __hip_atomic_fetch_add(p, v, __ATOMIC_RELAXED, __HIP_MEMORY_SCOPE_AGENT); }
__device__ __forceinline__ unsigned xb_xcc_id() { return (unsigned)__builtin_amdgcn_s_getreg((3 << 11) | 20) & 0xFu; }
#define XB_SPIN(cond, bar) do { unsigned _sp = 0; while (cond) { __builtin_amdgcn_s_sleep(1); \
    if ((++_sp & 255u) == 0u) { if (xb_ld(&(bar)[XB_TMO])) break; if (_sp > XB_SPIN_CAP) { atomicAdd(&(bar)[XB_TMO], 1u); break; } } } } while (0)
struct XcdBarrier { unsigned* bar; unsigned x; volatile LAS unsigned* st; };
__device__ __forceinline__ XcdBarrier xcd_barrier_post(unsigned* bar, volatile LAS unsigned* st) {
    XcdBarrier b; b.bar = bar; b.x = xb_xcc_id(); b.st = st;
    if (threadIdx.x == 0) (void)xb_add(&bar[XB_XCNT(b.x)], 1u);
    return b;
}
__device__ __forceinline__ void xcd_barrier_complete(unsigned* bar, unsigned x, unsigned& nloc, unsigned& nx) {
    const unsigned G = gridDim.x * gridDim.y * gridDim.z;
    unsigned sum, cnt, mine, sp = 0u;
    for (;;) {
        sum = 0u; cnt = 0u; mine = 0u;
#pragma unroll
        for (unsigned j = 0; j < 16; ++j) { const unsigned c = xb_ld(&bar[XB_XCNT(j)]); sum += c; cnt += (c > 0u) ? 1u : 0u; mine = (j == x) ? c : mine; }
        if (sum == G) break;
        __builtin_amdgcn_s_sleep(1);
        if ((++sp & 255u) == 0u) { if (xb_ld(&bar[XB_TMO])) break; if (sp > XB_SPIN_CAP) { atomicAdd(&bar[XB_TMO], 1u); break; } }
    }
    nloc = mine > 0u ? mine : 1u; nx = cnt > 0u ? cnt : 1u;
}
__device__ __forceinline__ void xcd_barrier(const XcdBarrier& b) {
    asm volatile("s_waitcnt vmcnt(0)" ::: "memory");
    __syncthreads();
    if (threadIdx.x == 0) {
        unsigned* bar = b.bar;
        __builtin_amdgcn_s_waitcnt(0);
        unsigned nloc = b.st[0], nx = b.st[1];
        if (nloc == 0u) { xcd_barrier_complete(bar, b.x, nloc, nx); b.st[0] = nloc; b.st[1] = nx; }
        const unsigned old = xb_add(&bar[XB_XSUB(b.x)], 1u);
        const unsigned gen = old / nloc;
        if (old + 1u == (gen + 1u) * nloc) {
            __builtin_amdgcn_fence(__ATOMIC_RELEASE, "agent");
            asm volatile("s_waitcnt vmcnt(0)" ::: "memory");
            const unsigned og = xb_add(&bar[XB_TOP], 1u);
            const unsigned tg = og / nx;
            if (og + 1u == (tg + 1u) * nx) xb_add(&bar[XB_TOPGEN], 1u);
            else XB_SPIN(xb_ld(&bar[XB_TOPGEN]) == tg, bar);
            __builtin_amdgcn_fence(__ATOMIC_ACQUIRE, "agent");
            xb_add(&bar[XB_XGEN(b.x)], 1u);
            asm volatile("s_waitcnt vmcnt(0)" ::: "memory");
        } else {
            XB_SPIN(xb_ld(&bar[XB_XGEN(b.x)]) == gen, bar);
            __builtin_amdgcn_fence(__ATOMIC_ACQUIRE, "agent");
            asm volatile("s_waitcnt vmcnt(0)" ::: "memory");
        }
    }
    __syncthreads();
}

namespace pg8 {
constexpr int BM = 256, BK = 64, HALF = 128, HTB = HALF * BK * 2, STAGE_BYTES = 8 * HTB, NXCD = 8, WGM = 8;
__host__ __device__ __forceinline__ int lds_byte(int r, int c) { const int st = (r >> 4) * 2 + (c >> 5), rr = r & 15, cc = c & 31, ob = rr * 64 + cc * 2; return st * 1024 + (ob ^ (((ob >> 9) & 1) << 5)); }
__host__ __device__ __forceinline__ void stage_rc(int b, int& R, int& C) { const int st = b / 1024, sb = b % 1024, swz = sb ^ (((sb >> 9) & 1) << 5); R = (st >> 1) * 16 + swz / 64; C = (st & 1) * 32 + (swz % 64) / 2; }
__host__ __device__ __forceinline__ int perm32(int rho) { const int n = rho >> 4, i = rho & 15; return 8 * (i >> 2) + 4 * n + (i & 3); }

struct Unit { int pm, pn, kind; const char* a; const char* b; };
struct Gemm { int K, lda, ldb; };

template <class Epi, class Sched, bool ALIGN_EPI>
__device__ __forceinline__ void gemm_phase(LAS unsigned char* lds, const Gemm g, const Sched& S, const Epi& E) {
    int tid_ = threadIdx.x; asm volatile("" : "+v"(tid_));
    const int tid = tid_, wid = __builtin_amdgcn_readfirstlane(tid >> 6), lane = tid & 63, wr = wid >> 2, wc = wid & 3, fr = lane & 15, fq = lane >> 4;
    const int K = g.K, nt = K / BK;
    unsigned voffA[2], voffB[2];
#pragma unroll
    for (int i = 0; i < 2; ++i) { int R, C; stage_rc(tid * 16 + i * 8192, R, C); const int Rb = Epi::PERM ? ((R & ~31) + perm32(R & 31)) : R;
        voffA[i] = (unsigned)(R * g.lda + C) * 2u; voffB[i] = (unsigned)(Rb * g.ldb + C) * 2u; }
    const size_t kstep = (size_t)(BK * 2);
    const size_t hstepA = (size_t)HALF * g.lda * 2, hstepB = (size_t)HALF * g.ldb * 2;
    const unsigned ldsw = (unsigned)wid * 1024u;
    const int aoff = lds_byte(wr * 64 + fr, fq * 8), boff = lds_byte(wc * 32 + fr, fq * 8);
#define PG8_SA(b, h) (((b) * 2 + (h)) * HTB)
#define PG8_SB(b, h) ((4 + (b) * 2 + (h)) * HTB)
#define PG8_STAGE(bufoff, gbase, voff) do { _Pragma("unroll") for (int _i = 0; _i < 2; ++_i) \
        __builtin_amdgcn_global_load_lds((const unsigned*)((const char*)(gbase) + (voff)[_i]), (LAS unsigned*)(lds + (bufoff) + ldsw + _i * 8192), 16, 0, 0); } while (0)
#define PG8_LDA(dst, b, h) do { _Pragma("unroll") for (int m = 0; m < 4; ++m) _Pragma("unroll") for (int k = 0; k < 2; ++k) dst[m][k] = *(const LAS bf16x8*)(lds + PG8_SA(b, h) + aoff + m * 2048 + k * 1024); } while (0)
#define PG8_LDB(dst, b, h) do { _Pragma("unroll") for (int n = 0; n < 2; ++n) _Pragma("unroll") for (int k = 0; k < 2; ++k) dst[n][k] = *(const LAS bf16x8*)(lds + PG8_SB(b, h) + boff + n * 2048 + k * 1024); } while (0)
#define PG8_MMA(ai, bj, At, Bt) do { __builtin_amdgcn_s_setprio(1); _Pragma("unroll") for (int m = 0; m < 4; ++m) _Pragma("unroll") for (int n = 0; n < 2; ++n) _Pragma("unroll") for (int k = 0; k < 2; ++k) \
        acc[ai][bj][m][n] = __builtin_amdgcn_mfma_f32_16x16x32_bf16(Bt[n][k], At[m][k], acc[ai][bj][m][n], 0, 0, 0); __builtin_amdgcn_s_setprio(0); } while (0)
#define PG8_WAIT_V(n) asm volatile("s_waitcnt vmcnt(" #n ")" ::: "memory")
#define PG8_WAIT_L(n) asm volatile("s_waitcnt lgkmcnt(" #n ")" ::: "memory")
#define PG8_BAR __builtin_amdgcn_s_barrier()
#define PG8_SCHED __builtin_amdgcn_sched_barrier(0)
    Unit cur, nxt; int ui = 0;
    if (!S.next(0, cur)) return;
    f32x4 acc[2][2][4][2];
#pragma unroll
    for (int a = 0; a < 2; ++a)
#pragma unroll
        for (int b = 0; b < 2; ++b)
#pragma unroll
            for (int m = 0; m < 4; ++m)
#pragma unroll
                for (int n = 0; n < 2; ++n) acc[a][b][m][n] = (f32x4){0.f, 0.f, 0.f, 0.f};
    bf16x8 At[4][2], B0[2][2], B1[2][2];
    const char* cA = cur.a; const char* cB = cur.b;
    PG8_STAGE(PG8_SB(0, 0), cB, voffB); PG8_STAGE(PG8_SB(0, 1), cB + hstepB, voffB); PG8_STAGE(PG8_SA(0, 0), cA, voffA); PG8_STAGE(PG8_SA(0, 1), cA + hstepA, voffA);
    if (wr == 1) PG8_BAR;
    PG8_WAIT_V(2); PG8_BAR;
    PG8_STAGE(PG8_SB(1, 0), cB + kstep, voffB); PG8_STAGE(PG8_SA(1, 0), cA + kstep, voffA); PG8_STAGE(PG8_SB(1, 1), cB + hstepB + kstep, voffB);
    PG8_WAIT_V(6); PG8_BAR;
    for (;;) {
        const bool has_next = S.next(ui + 1, nxt);
        const char* nA = has_next ? nxt.a : cA; const char* nB = has_next ? nxt.b : cB;
        for (int t = 0; t < nt; t += 2) {
            const bool last = (t == nt - 2);
            const char* a1 = cA + (size_t)(t + 1) * kstep;
            const char* a2 = last ? nA : cA + (size_t)(t + 2) * kstep; const char* b2 = last ? nB : cB + (size_t)(t + 2) * kstep;
            const char* a3 = a2 + kstep; const char* b3 = b2 + kstep;
            PG8_LDB(B0, 0, 0); PG8_LDB(B1, 0, 1); PG8_SCHED; PG8_LDA(At, 0, 0); PG8_STAGE(PG8_SA(1, 1), a1 + hstepA, voffA);
            PG8_WAIT_V(8); PG8_WAIT_L(0); PG8_BAR; PG8_MMA(0, 0, At, B0); PG8_MMA(0, 1, At, B1); PG8_BAR; PG8_SCHED;
            PG8_LDA(At, 0, 1); PG8_STAGE(PG8_SB(0, 0), b2, voffB); PG8_STAGE(PG8_SB(0, 1), b2 + hstepB, voffB); PG8_STAGE(PG8_SA(0, 0), a2, voffA);
            PG8_WAIT_V(8); PG8_WAIT_L(0); PG8_BAR; PG8_MMA(1, 0, At, B0); PG8_MMA(1, 1, At, B1); PG8_BAR; PG8_SCHED;
            PG8_LDB(B0, 1, 0); PG8_LDB(B1, 1, 1); PG8_SCHED; PG8_LDA(At, 1, 0); PG8_STAGE(PG8_SA(0, 1), a2 + hstepA, voffA);
            PG8_WAIT_V(8); PG8_WAIT_L(0); PG8_BAR; PG8_MMA(0, 0, At, B0); PG8_MMA(0, 1, At, B1); PG8_BAR; PG8_SCHED;
            PG8_LDA(At, 1, 1); PG8_STAGE(PG8_SB(1, 0), b3, voffB); PG8_STAGE(PG8_SB(1, 1), b3 + hstepB, voffB); PG8_STAGE(PG8_SA(1, 0), a3, voffA);
            PG8_WAIT_V(8); PG8_WAIT_L(0); PG8_BAR; PG8_MMA(1, 0, At, B0); PG8_MMA(1, 1, At, B1); PG8_BAR; PG8_SCHED;
        }
        if constexpr (ALIGN_EPI) { if (wr == 0) PG8_BAR; }
        E(acc, cur, wr, wc, fr, fq);
        if (!has_next) break;
#pragma unroll
        for (int a = 0; a < 2; ++a)
#pragma unroll
            for (int b = 0; b < 2; ++b)
#pragma unroll
                for (int m = 0; m < 4; ++m)
#pragma unroll
                    for (int n = 0; n < 2; ++n) acc[a][b][m][n] = (f32x4){0.f, 0.f, 0.f, 0.f};
        cur = nxt; cA = nA; cB = nB; ++ui;
        if constexpr (ALIGN_EPI) { if (wr == 1) PG8_BAR; }
    }
    PG8_WAIT_V(0);
    if constexpr (!ALIGN_EPI) { if (wr == 0) PG8_BAR; }
    PG8_BAR;
#undef PG8_SA
#undef PG8_SB
#undef PG8_STAGE
#undef PG8_LDA
#undef PG8_LDB
#undef PG8_MMA
#undef PG8_WAIT_V
#undef PG8_WAIT_L
#undef PG8_BAR
#undef PG8_SCHED
}
}
using pg8::Unit;

struct SchedZ {
    int G, c; const char* A; const char* B;
    __device__ bool next(int i, Unit& u) const {
        const int L = i * G + c; constexpr int nM = 65, nN = 30, nwg = nM * nN;
        if (L >= nwg + 32) return false;
        if (L < nwg) {
            int wgid = L; { const int q = nwg / 8, r = nwg % 8, xcd = wgid % 8, off = wgid / 8; wgid = (xcd < r ? xcd * (q + 1) : r * (q + 1) + (xcd - r) * q) + off; }
            const int nig = 8 * nN, gid = wgid / nig, fm = gid * 8, gsz = (nM - fm) < 8 ? (nM - fm) : 8;
            u.pm = fm + ((wgid % nig) % gsz); u.pn = (wgid % nig) / gsz; u.kind = 0;
        } else { const int Lm = L - nwg; u.pm = 65 + (Lm >> 2); u.pn = 30 + (Lm & 3); u.kind = 1; }
        u.a = A + (size_t)u.pm * 256 * DM * 2; u.b = B + (size_t)u.pn * 256 * DM * 2; return true;
    }
};
struct SchedBr {
    int G, c; const char* Z; const char* W;
    __device__ bool next(int i, Unit& u) const {
        const int tri = (i / 3) * G + c, br = i % 3; if (tri >= 256) return false;
        u.pm = tri >> 2; u.pn = tri & 3; u.kind = br;
        const int acol = br == 0 ? ZQ : (br == 1 ? ZGC : ZQM);
        u.a = Z + ((size_t)u.pm * 256 * INW + acol) * 2; u.b = W + ((size_t)(br * 1024 + u.pn * 256) * 512) * 2; return true;
    }
};
struct SchedOut {
    int G, c; const char* Z; const char* W;
    __device__ bool next(int i, Unit& u) const {
        const int L = i * G + c; if (L >= 256) return false;
        u.pm = L >> 2; u.pn = L & 3; u.kind = 0;
        u.a = Z + ((size_t)u.pm * 256 * INW + ZG2) * 2; u.b = W + ((size_t)(u.pn * 256) * DM) * 2; return true;
    }
};

struct EpiZ {
    static constexpr bool PERM = true;
    bf16_t* Z; float* mk; float* mv; bf16_t* KB; bf16_t* VTG;
    __device__ __forceinline__ void operator()(const f32x4 (&acc)[2][2][4][2], const Unit& u, int wr, int wc, int fr, int fq) const {
        if (u.kind == 0) {
            const int row0 = u.pm * 256 + wr * 64 + fr, col0 = u.pn * 256 + wc * 32 + 8 * fq;
#pragma unroll
            for (int ai = 0; ai < 2; ++ai)
#pragma unroll
                for (int m = 0; m < 4; ++m) { bf16_t* rowp = Z + (size_t)(row0 + ai * 128 + m * 16) * INW + col0;
#pragma unroll
                    for (int bj = 0; bj < 2; ++bj) { const f32x4 v0 = acc[ai][bj][m][0], v1 = acc[ai][bj][m][1];
                        u32x4 w; w.x = cvt_pk_bf16(v0[0], v0[1]); w.y = cvt_pk_bf16(v0[2], v0[3]); w.z = cvt_pk_bf16(v1[0], v1[1]); w.w = cvt_pk_bf16(v1[2], v1[3]);
                        *(u32x4*)(rowp + bj * 128) = w; } }
        } else {
            const int mrow0 = (u.pm - 65) * 256 + wr * 64 + fr, col0 = (u.pn - 30) * 256 + wc * 32 + 8 * fq;
#pragma unroll
            for (int ai = 0; ai < 2; ++ai)
#pragma unroll
                for (int m = 0; m < 4; ++m) { const int mrow = mrow0 + ai * 128 + m * 16;
#pragma unroll
                    for (int bj = 0; bj < 2; ++bj) { const int cc = col0 + bj * 128; const f32x4 v0 = acc[ai][bj][m][0], v1 = acc[ai][bj][m][1];
                        if (cc < 512) {
                            *(f32x4*)(mk + (size_t)mrow * 512 + cc) = v0; *(f32x4*)(mk + (size_t)mrow * 512 + cc + 4) = v1;
                            u32x4 w; w.x = cvt_pk_bf16(v0[0], v0[1]); w.y = cvt_pk_bf16(v0[2], v0[3]); w.z = cvt_pk_bf16(v1[0], v1[1]); w.w = cvt_pk_bf16(v1[2], v1[3]);
                            *(u32x4*)(KB + (size_t)mrow * 512 + cc) = w;
                        } else {
                            const int e0 = cc - 512; *(f32x4*)(mv + (size_t)mrow * 512 + e0) = v0; *(f32x4*)(mv + (size_t)mrow * 512 + e0 + 4) = v1;
                            const int b = mrow >> 8, mm = mrow & 255;
                            bf16_t* vp = VTG + ((size_t)(b * 512 + e0)) * 256 + mm;
#pragma unroll
                            for (int t = 0; t < 4; ++t) { vp[(size_t)t * 256] = f2bf(v0[t]); vp[(size_t)(t + 4) * 256] = f2bf(v1[t]); }
                        } } }
        }
    }
};
struct EpiBr {
    static constexpr bool PERM = true;
    bf16_t* Z;
    __device__ __forceinline__ void operator()(const f32x4 (&acc)[2][2][4][2], const Unit& u, int wr, int wc, int fr, int fq) const {
        const int br = u.kind; const int row0 = u.pm * 256 + wr * 64 + fr, col0 = u.pn * 256 + wc * 32 + 8 * fq;
#pragma unroll
        for (int ai = 0; ai < 2; ++ai)
#pragma unroll
            for (int m = 0; m < 4; ++m) { bf16_t* rowp = Z + (size_t)(row0 + ai * 128 + m * 16) * INW + ZG0 + br * 1024 + col0;
#pragma unroll
                for (int bj = 0; bj < 2; ++bj) { const f32x4 v0 = acc[ai][bj][m][0], v1 = acc[ai][bj][m][1];
                    float g[8]; unpack8(*(const u32x4*)(rowp + bj * 128), g);
                    float o[8];
#pragma unroll
                    for (int t = 0; t < 4; ++t) { o[t] = sigmoidf_(g[t]) * v0[t]; o[t + 4] = sigmoidf_(g[t + 4]) * v1[t]; }
                    if (br > 0) { float pv[8]; unpack8(*(const u32x4*)(rowp - 1024 + bj * 128), pv);
#pragma unroll
                        for (int t = 0; t < 8; ++t) o[t] += pv[t]; }
                    *(u32x4*)(rowp + bj * 128) = pack8(o); } }
    }
};
struct EpiOut {
    static constexpr bool PERM = false;
    const float* x; float* y; float* ss;
    __device__ __forceinline__ void operator()(const f32x4 (&acc)[2][2][4][2], const Unit& u, int wr, int wc, int fr, int fq) const {
#pragma unroll
        for (int ai = 0; ai < 2; ++ai)
#pragma unroll
            for (int m = 0; m < 4; ++m) { const int row = u.pm * 256 + ai * 128 + wr * 64 + m * 16 + fr; float q = 0.f;
#pragma unroll
                for (int bj = 0; bj < 2; ++bj)
#pragma unroll
                    for (int n = 0; n < 2; ++n) { const size_t off = (size_t)row * DM + u.pn * 256 + bj * 128 + wc * 32 + n * 16 + 4 * fq;
                        const f32x4 v = *(const f32x4*)(x + off) + acc[ai][bj][m][n]; *(f32x4*)(y + off) = v;
                        q += (v[0] * v[0] + v[1] * v[1]) + (v[2] * v[2] + v[3] * v[3]); }
                q += __shfl_xor(q, 16); q += __shfl_xor(q, 32);
                if (fq == 0) atomicAdd(ss + row, q); }
    }
};

__device__ __forceinline__ void p0_transpose_item(const float* W, int K, int N, bf16_t* WT, int row_off, LAS float* scr, int item, int lane) {
    const int nblk = N / 32, kb = item / nblk, nb = item % nblk, k0 = 64 * kb, n0 = 32 * nb;
#pragma unroll 8
    for (int i = 0; i < 32; ++i) { const int kk = 2 * i + (lane >> 5); scr[kk * 33 + (lane & 31)] = W[(size_t)(k0 + kk) * N + n0 + (lane & 31)]; }
    WAVE_LDS_SYNC();
    const int c = lane & 7;
#pragma unroll
    for (int j = 0; j < 4; ++j) { const int n = (lane >> 3) + 8 * j; const LAS float* s = scr + (8 * c) * 33 + n;
        u32x4 o; o.x = cvt_pk_bf16(s[0 * 33], s[1 * 33]); o.y = cvt_pk_bf16(s[2 * 33], s[3 * 33]); o.z = cvt_pk_bf16(s[4 * 33], s[5 * 33]); o.w = cvt_pk_bf16(s[6 * 33], s[7 * 33]);
        *(u32x4*)(WT + (size_t)(row_off + n0 + n) * K + k0 + 8 * c) = o; }
    WAVE_LDS_SYNC();
}
__device__ __forceinline__ void rms_row_to_bf16(const float* xrow, const float* w, bf16_t* orow, int lane) {
    const f32x4* xr = (const f32x4*)xrow + lane; const f32x4* wr = (const f32x4*)w + lane;
    f32x4 v[4]; float s = 0.f;
#pragma unroll
    for (int j = 0; j < 4; ++j) { v[j] = xr[64 * j]; s += (v[j][0] * v[j][0] + v[j][1] * v[j][1]) + (v[j][2] * v[j][2] + v[j][3] * v[j][3]); }
    const float rstd = rsqrtf(wave_sum(s) * (1.f / DM) + EPS);
    u32x2* o8 = (u32x2*)orow + lane;
#pragma unroll
    for (int j = 0; j < 4; ++j) { const f32x4 ww = wr[64 * j]; u32x2 o; o.x = cvt_pk_bf16(v[j][0] * rstd * ww[0], v[j][1] * rstd * ww[1]); o.y = cvt_pk_bf16(v[j][2] * rstd * ww[2], v[j][3] * rstd * ww[3]); o8[64 * j] = o; }
}

constexpr int RS = 136;

__device__ __forceinline__ void kv_task(const Params& p, LAS unsigned char* lds, int task, int tid, int lane, int wid) {
    const int n = task & 15, bh = task >> 4, h = bh & 3, b = bh >> 2;
    const bf16_t* Z = (const bf16_t*)(p.ws + WS_Z); const float* COS = (const float*)(p.ws + WS_COS); const float* SIN = (const float*)(p.ws + WS_SIN);
    float* KVT = p.out + O_YP;
    LAS bf16_t* Kt = (LAS bf16_t*)lds; LAS bf16_t* Vt = (LAS bf16_t*)(lds + 128 * RS * 2);
    const float lg = log1pf(-exp2f(-5.f - (float)h));
    const int j = (wid & 1) * 64 + lane, cg4 = wid >> 1;
    const bf16_t* zr = Z + (size_t)(b * TP + n * 128 + j) * INW + h * 128;
    const float kdec = expf((float)(127 - j) * lg);
    const int pos = n * 128 + j;
#pragma unroll
    for (int it = 0; it < 2; ++it) { const int d0 = (cg4 + 4 * it) * 8;
        float k1[8], k2[8]; unpack8(*(const u32x4*)(zr + ZK + d0), k1); unpack8(*(const u32x4*)(zr + ZK + 64 + d0), k2);
        const f32x4 c0 = *(const f32x4*)(COS + pos * 64 + d0), c1 = *(const f32x4*)(COS + pos * 64 + d0 + 4), s0 = *(const f32x4*)(SIN + pos * 64 + d0), s1 = *(const f32x4*)(SIN + pos * 64 + d0 + 4);
#pragma unroll
        for (int t = 0; t < 8; ++t) { const float cs = t < 4 ? c0[t & 3] : c1[t & 3], sn = t < 4 ? s0[t & 3] : s1[t & 3];
            Kt[(d0 + t) * RS + j] = f2bf((k1[t] * cs - k2[t] * sn) * kdec); Kt[(d0 + 64 + t) * RS + j] = f2bf((k1[t] * sn + k2[t] * cs) * kdec); } }
#pragma unroll
    for (int it = 0; it < 4; ++it) { const int e0 = (cg4 + 4 * it) * 8; const u32x4 w = *(const u32x4*)(zr + ZV + e0);
        Vt[(e0 + 0) * RS + j] = (bf16_t)(w.x & 0xffff); Vt[(e0 + 1) * RS + j] = (bf16_t)(w.x >> 16); Vt[(e0 + 2) * RS + j] = (bf16_t)(w.y & 0xffff); Vt[(e0 + 3) * RS + j] = (bf16_t)(w.y >> 16);
        Vt[(e0 + 4) * RS + j] = (bf16_t)(w.z & 0xffff); Vt[(e0 + 5) * RS + j] = (bf16_t)(w.z >> 16); Vt[(e0 + 6) * RS + j] = (bf16_t)(w.w & 0xffff); Vt[(e0 + 7) * RS + j] = (bf16_t)(w.w >> 16); }
    __syncthreads();
    const int r = lane & 15, q = lane >> 4;
    f32x4 acc[8];
#pragma unroll
    for (int nt = 0; nt < 8; ++nt) acc[nt] = (f32x4){0.f, 0.f, 0.f, 0.f};
#pragma unroll
    for (int ks = 0; ks < 4; ++ks) { const bf16x8 a = *(const LAS bf16x8*)(Vt + (16 * wid + r) * RS + 32 * ks + 8 * q);
#pragma unroll
        for (int nt = 0; nt < 8; ++nt) { const bf16x8 bb = *(const LAS bf16x8*)(Kt + (16 * nt + r) * RS + 32 * ks + 8 * q); acc[nt] = MFMA16(a, bb, acc[nt]); } }
    float* dst = KVT + (size_t)task * 16384;
#pragma unroll
    for (int nt = 0; nt < 8; ++nt)
#pragma unroll
        for (int i = 0; i < 4; ++i) dst[(16 * wid + 4 * q + i) * 128 + 16 * nt + r] = acc[nt][i];
    __syncthreads();
}

__device__ __forceinline__ void o_task(const Params& p, LAS unsigned char* lds, int task, int tid, int lane, int wid) {
    const int n = task & 15, bh = task >> 4, h = bh & 3, b = bh >> 2;
    bf16_t* Z = (bf16_t*)(p.ws + WS_Z); const float* COS = (const float*)(p.ws + WS_COS); const float* SIN = (const float*)(p.ws + WS_SIN);
    const float* gnw = p.in[9];
    LAS bf16_t* Qs = (LAS bf16_t*)lds; LAS bf16_t* Ks = (LAS bf16_t*)(lds + 128 * RS * 2); LAS bf16_t* Vt = (LAS bf16_t*)(lds + 2 * 128 * RS * 2);
    LAS bf16_t* Ps = (LAS bf16_t*)(lds + 3 * 128 * RS * 2 + wid * (16 * RS * 2));
    const float lg = log1pf(-exp2f(-5.f - (float)h));
    const size_t zrow0 = (size_t)b * TP + n * 128;
#pragma unroll
    for (int it = 0; it < 2; ++it) { const int item = tid + 512 * it, i = item >> 3, d0 = (item & 7) * 8;
        const bf16_t* zp = Z + (zrow0 + i) * INW + h * 128 + d0; const int pos = n * 128 + i;
        float q1[8], q2[8], k1[8], k2[8]; unpack8(*(const u32x4*)(zp + ZQ), q1); unpack8(*(const u32x4*)(zp + ZQ + 64), q2); unpack8(*(const u32x4*)(zp + ZK), k1); unpack8(*(const u32x4*)(zp + ZK + 64), k2);
        const f32x4 c0 = *(const f32x4*)(COS + pos * 64 + d0), c1 = *(const f32x4*)(COS + pos * 64 + d0 + 4), s0 = *(const f32x4*)(SIN + pos * 64 + d0), s1 = *(const f32x4*)(SIN + pos * 64 + d0 + 4);
        const float qsc = 0.08838834764831845f * expf((float)(i + 1) * lg), ksc = expf(-(float)(i + 1) * lg);
        float qa[8], qb[8], ka[8], kb[8];
#pragma unroll
        for (int t = 0; t < 8; ++t) { const float cs = t < 4 ? c0[t & 3] : c1[t & 3], sn = t < 4 ? s0[t & 3] : s1[t & 3];
            qa[t] = (q1[t] * cs - q2[t] * sn) * qsc; qb[t] = (q1[t] * sn + q2[t] * cs) * qsc; ka[t] = (k1[t] * cs - k2[t] * sn) * ksc; kb[t] = (k1[t] * sn + k2[t] * cs) * ksc; }
        *(LAS u32x4*)(Qs + i * RS + d0) = pack8(qa); *(LAS u32x4*)(Qs + i * RS + 64 + d0) = pack8(qb);
        *(LAS u32x4*)(Ks + i * RS + d0) = pack8(ka); *(LAS u32x4*)(Ks + i * RS + 64 + d0) = pack8(kb); }
    { const int j = (wid & 1) * 64 + lane, cg4 = wid >> 1; const bf16_t* zr = Z + (zrow0 + j) * INW + ZV + h * 128;
#pragma unroll
      for (int it = 0; it < 4; ++it) { const int e0 = (cg4 + 4 * it) * 8; const u32x4 w = *(const u32x4*)(zr + e0);
        Vt[(e0 + 0) * RS + j] = (bf16_t)(w.x & 0xffff); Vt[(e0 + 1) * RS + j] = (bf16_t)(w.x >> 16); Vt[(e0 + 2) * RS + j] = (bf16_t)(w.y & 0xffff); Vt[(e0 + 3) * RS + j] = (bf16_t)(w.y >> 16);
        Vt[(e0 + 4) * RS + j] = (bf16_t)(w.z & 0xffff); Vt[(e0 + 5) * RS + j] = (bf16_t)(w.z >> 16); Vt[(e0 + 6) * RS + j] = (bf16_t)(w.w & 0xffff); Vt[(e0 + 7) * RS + j] = (bf16_t)(w.w >> 16); } }
    u32x4 stv[4];
    { const bf16_t* ST = (const bf16_t*)((const unsigned char*)(p.out + O_YP) + 32 * MiB) + (size_t)task * 16384;
#pragma unroll
      for (int it = 0; it < 4; ++it) { const int item = tid + 512 * it; stv[it] = n > 0 ? *(const u32x4*)(ST + (size_t)item * 8) : (u32x4){0u, 0u, 0u, 0u}; } }
    __syncthreads();
    const int r = lane & 15, q = lane >> 4;
    f32x4 acc[8];
#pragma unroll
    for (int nt = 0; nt < 8; ++nt) acc[nt] = (f32x4){0.f, 0.f, 0.f, 0.f};
#pragma unroll
    for (int ks = 0; ks < 4; ++ks) { const bf16x8 a = *(const LAS bf16x8*)(Qs + (16 * wid + r) * RS + 32 * ks + 8 * q);
#pragma unroll
        for (int nt = 0; nt < 8; ++nt) { const bf16x8 bb = *(const LAS bf16x8*)(Ks + (16 * nt + r) * RS + 32 * ks + 8 * q); acc[nt] = MFMA16(a, bb, acc[nt]); } }
#pragma unroll
    for (int nt = 0; nt < 8; ++nt)
#pragma unroll
        for (int i = 0; i < 4; ++i) { const int ii = 16 * wid + 4 * q + i, jj = 16 * nt + r; Ps[(4 * q + i) * RS + jj] = f2bf(jj <= ii ? acc[nt][i] : 0.f); }
    __syncthreads();
    LAS bf16_t* St = Ks;
#pragma unroll
    for (int it = 0; it < 4; ++it) { const int item = tid + 512 * it, e = item >> 4, d0 = (item & 15) * 8; *(LAS u32x4*)(St + e * RS + d0) = stv[it]; }
    __syncthreads();
#pragma unroll
    for (int nt = 0; nt < 8; ++nt) acc[nt] = (f32x4){0.f, 0.f, 0.f, 0.f};
#pragma unroll
    for (int ks = 0; ks < 4; ++ks) { const bf16x8 a = *(const LAS bf16x8*)(Ps + r * RS + 32 * ks + 8 * q);
#pragma unroll
        for (int nt = 0; nt < 8; ++nt) { const bf16x8 bb = *(const LAS bf16x8*)(Vt + (16 * nt + r) * RS + 32 * ks + 8 * q); acc[nt] = MFMA16(a, bb, acc[nt]); } }
#pragma unroll
    for (int ks = 0; ks < 4; ++ks) { const bf16x8 a = *(const LAS bf16x8*)(Qs + (16 * wid + r) * RS + 32 * ks + 8 * q);
#pragma unroll
        for (int nt = 0; nt < 8; ++nt) { const bf16x8 bb = *(const LAS bf16x8*)(St + (16 * nt + r) * RS + 32 * ks + 8 * q); acc[nt] = MFMA16(a, bb, acc[nt]); } }
    WAVE_LDS_SYNC();
#pragma unroll
    for (int i = 0; i < 4; ++i) { float s = 0.f;
#pragma unroll
        for (int nt = 0; nt < 8; ++nt) s += acc[nt][i];
        const float mean = sum16(s) * (1.f / 128.f); float v = 0.f;
#pragma unroll
        for (int nt = 0; nt < 8; ++nt) { const float d = acc[nt][i] - mean; v += d * d; }
        const float rstd = rsqrtf(sum16(v) * (1.f / 128.f) + EPS);
#pragma unroll
        for (int nt = 0; nt < 8; ++nt) Ps[(4 * q + i) * RS + 16 * nt + r] = f2bf((acc[nt][i] - mean) * rstd); }
    WAVE_LDS_SYNC();
#pragma unroll
    for (int it = 0; it < 4; ++it) { const int rowl = (lane >> 4) + 4 * it, e0 = (lane & 15) * 8;
        float nv[8], g[8]; unpack8(*(const LAS u32x4*)(Ps + rowl * RS + e0), nv);
        bf16_t* zp = Z + (zrow0 + 16 * wid + rowl) * INW + h * 128 + e0; unpack8(*(const u32x4*)(zp + ZGR), g);
        const f32x4 w0 = *(const f32x4*)(gnw + h * 128 + e0), w1 = *(const f32x4*)(gnw + h * 128 + e0 + 4);
        float o[8];
#pragma unroll
        for (int t = 0; t < 8; ++t) o[t] = nv[t] * (t < 4 ? w0[t & 3] : w1[t & 3]) * siluf_(g[t]);
        *(u32x4*)(zp + ZQ) = pack8(o); }
    __syncthreads();
}

__device__ __forceinline__ void conv_task(const Params& p, LAS unsigned char* lds, int task, int tid, int lane, int wid) {
    const int b = task >> 6, t0 = (task & 63) * 32;
    bf16_t* Z = (bf16_t*)(p.ws + WS_Z);
    LAS float* ut = (LAS float*)lds;
    { u32x4 av[8], gv[8];
#pragma unroll
      for (int k = 0; k < 8; ++k) { const int item = tid + 512 * k, rr = item >> 6, c0 = (item & 63) * 8, t = t0 - 30 + rr;
        if (rr < 62 && t >= 0) { const bf16_t* zp = Z + (size_t)(b * TP + t) * INW + c0; av[k] = *(const u32x4*)(zp + ZA); gv[k] = *(const u32x4*)(zp + ZB); }
        else { av[k] = (u32x4){0u, 0u, 0u, 0u}; gv[k] = (u32x4){0u, 0u, 0u, 0u}; } }
#pragma unroll
      for (int k = 0; k < 8; ++k) { const int item = tid + 512 * k, rr = item >> 6, c0 = (item & 63) * 8, t = t0 - 30 + rr;
        if (rr < 62) { float a[8], g[8], u[8]; unpack8(av[k], a); unpack8(gv[k], g);
#pragma unroll
            for (int i = 0; i < 8; ++i) u[i] = a[i] * sigmoidf_(g[i]);
            *(LAS f32x4*)(ut + rr * 512 + c0) = (f32x4){u[0], u[1], u[2], u[3]}; *(LAS f32x4*)(ut + rr * 512 + c0 + 4) = (f32x4){u[4], u[5], u[6], u[7]};
            if (t >= TP - 30) { float* cp = p.out + O_CONVP + ((size_t)b * 30 + (t - (TP - 30))) * 512 + c0; *(f32x4*)cp = (f32x4){u[0], u[1], u[2], u[3]}; *(f32x4*)(cp + 4) = (f32x4){u[4], u[5], u[6], u[7]}; } } } }
    __syncthreads();
    { const int c = tid; float w[31];
#pragma unroll
      for (int k = 0; k < 31; ++k) w[k] = p.in[10][k * 512 + c];
      const float bias = p.in[11][c];
#pragma unroll 1
      for (int g4 = 0; g4 < 8; ++g4) { float uu[34];
#pragma unroll
        for (int k = 0; k < 34; ++k) uu[k] = ut[(4 * g4 + k) * 512 + c];
        float y0 = bias, y1 = bias, y2 = bias, y3 = bias;
#pragma unroll
        for (int k = 0; k < 31; ++k) { y0 += w[k] * uu[k]; y1 += w[k] * uu[k + 1]; y2 += w[k] * uu[k + 2]; y3 += w[k] * uu[k + 3]; }
        ut[(4 * g4 + 0) * 512 + c] = y0; ut[(4 * g4 + 1) * 512 + c] = y1; ut[(4 * g4 + 2) * 512 + c] = y2; ut[(4 * g4 + 3) * 512 + c] = y3; } }
    __syncthreads();
    { const int c0 = lane * 8; const float* lw = p.in[12] + c0; const float* lb = p.in[13] + c0;
      const f32x4 w0 = *(const f32x4*)lw, w1 = *(const f32x4*)(lw + 4), b0 = *(const f32x4*)lb, b1 = *(const f32x4*)(lb + 4);
      u32x4 gpre[4];
#pragma unroll
      for (int k = 0; k < 4; ++k) gpre[k] = *(const u32x4*)(Z + (size_t)(b * TP + t0 + wid + 8 * k) * INW + ZGC + c0);
#pragma unroll
      for (int k4 = 0; k4 < 4; ++k4) { const int tt = wid + 8 * k4; const f32x4 x0 = *(const LAS f32x4*)(ut + tt * 512 + c0), x1 = *(const LAS f32x4*)(ut + tt * 512 + c0 + 4);
        const float mean = wave_sum((x0[0] + x0[1]) + (x0[2] + x0[3]) + (x1[0] + x1[1]) + (x1[2] + x1[3])) * (1.f / 512.f);
        const f32x4 d0 = x0 - mean, d1 = x1 - mean;
        const float rstd = rsqrtf(wave_sum((d0[0] * d0[0] + d0[1] * d0[1]) + (d0[2] * d0[2] + d0[3] * d0[3]) + (d1[0] * d1[0] + d1[1] * d1[1]) + (d1[2] * d1[2] + d1[3] * d1[3])) * (1.f / 512.f) + EPS);
        bf16_t* zp = Z + (size_t)(b * TP + t0 + tt) * INW + ZGC + c0; float g[8]; unpack8(gpre[k4], g);
        float o[8];
#pragma unroll
        for (int t = 0; t < 8; ++t) { const float y = (t < 4 ? d0[t & 3] : d1[t & 3]) * rstd * (t < 4 ? w0[t & 3] : w1[t & 3]) + (t < 4 ? b0[t & 3] : b1[t & 3]); o[t] = siluf_(y) * siluf_(g[t]); }
        *(u32x4*)zp = pack8(o); } }
    __syncthreads();
}

__device__ __forceinline__ void attn_task(const Params& p, LAS unsigned char* lds, int task, int lane, int wid) {
    const int tile = task & 15, bh = task >> 4, h = bh & 3, b = bh >> 2;
    bf16_t* Z = (bf16_t*)(p.ws + WS_Z); const bf16_t* KB = (const bf16_t*)(p.ws + WS_KB); const bf16_t* VTG = (const bf16_t*)(p.ws + WS_VTG);
    constexpr int PS = 264;
    LAS bf16_t* Ps = (LAS bf16_t*)(lds + wid * (16 * PS * 2));
    const int r = lane & 15, q = lane >> 4;
    const size_t row0 = (size_t)b * TP + tile * 128 + 16 * wid;
    bf16x8 qf[4];
#pragma unroll
    for (int ks = 0; ks < 4; ++ks) qf[ks] = *(const bf16x8*)(Z + (row0 + r) * INW + ZQM + h * 128 + 32 * ks + 8 * q);
    f32x4 sc[16];
#pragma unroll
    for (int nt = 0; nt < 16; ++nt) { sc[nt] = (f32x4){0.f, 0.f, 0.f, 0.f}; const bf16_t* kp = KB + (size_t)(b * NMEM + 16 * nt + r) * 512 + h * 128 + 8 * q;
#pragma unroll
        for (int ks = 0; ks < 4; ++ks) { const bf16x8 bb = *(const bf16x8*)(kp + 32 * ks); sc[nt] = MFMA16(qf[ks], bb, sc[nt]); } }
    const float scale = 0.08838834764831845f;
    float inv[4];
#pragma unroll
    for (int i = 0; i < 4; ++i) { float mx = sc[0][i];
#pragma unroll
        for (int nt = 1; nt < 16; ++nt) mx = fmaxf(mx, sc[nt][i]);
        mx = max16(mx); float sum = 0.f;
#pragma unroll
        for (int nt = 0; nt < 16; ++nt) { const float e = __expf((sc[nt][i] - mx) * scale); sum += e; Ps[(4 * q + i) * PS + 16 * nt + r] = f2bf(e); }
        inv[i] = 1.0f / sum16(sum); }
    WAVE_LDS_SYNC();
    f32x4 o[8];
#pragma unroll
    for (int nt = 0; nt < 8; ++nt) o[nt] = (f32x4){0.f, 0.f, 0.f, 0.f};
#pragma unroll
    for (int ks = 0; ks < 8; ++ks) { const bf16x8 a = *(const LAS bf16x8*)(Ps + r * PS + 32 * ks + 8 * q);
#pragma unroll
        for (int nt = 0; nt < 8; ++nt) { const bf16x8 bb = *(const bf16x8*)(VTG + ((size_t)bh * 128 + 16 * nt + r) * 256 + 32 * ks + 8 * q); o[nt] = MFMA16(a, bb, o[nt]); } }
    WAVE_LDS_SYNC();
#pragma unroll
    for (int i = 0; i < 4; ++i)
#pragma unroll
        for (int nt = 0; nt < 8; ++nt) Ps[(4 * q + i) * PS + 16 * nt + r] = f2bf(o[nt][i] * inv[i]);
    WAVE_LDS_SYNC();
#pragma unroll
    for (int it = 0; it < 4; ++it) { const int rowl = (lane >> 4) + 4 * it, e0 = (lane & 15) * 8;
        float ov[8], g[8]; unpack8(*(const LAS u32x4*)(Ps + rowl * PS + e0), ov);
        bf16_t* zp = Z + (row0 + rowl) * INW + h * 128 + e0; unpack8(*(const u32x4*)(zp + ZGM), g);
        float oo[8];
#pragma unroll
        for (int t = 0; t < 8; ++t) oo[t] = ov[t] * siluf_(g[t]);
        *(u32x4*)(zp + ZQM) = pack8(oo); }
    WAVE_LDS_SYNC();
}

__device__ __forceinline__ void ret_sample_pair(const Params& p, LAS unsigned char* lds, int tp, int lane, int wid) {
    const int task = 2 * tp + (wid >> 2), part = wid & 3, b = task >> 2, h = task & 3;
    LAS float* wl = (LAS float*)(lds + wid * 4096); LAS float* red = (LAS float*)(lds + 32768);
    bf16_t* zp = (bf16_t*)(p.ws + WS_Z) + (size_t)(MP + b) * INW + h * 128;
    const float* COS = (const float*)(p.ws + WS_COS); const float* SIN = (const float*)(p.ws + WS_SIN);
    const float q1 = bf2f(zp[ZQ + lane]), q2 = bf2f(zp[ZQ + 64 + lane]), k1 = bf2f(zp[ZK + lane]), k2 = bf2f(zp[ZK + 64 + lane]);
    const float cs = COS[2048 * 64 + lane], sn = SIN[2048 * 64 + lane];
    const float qa = (q1 * cs - q2 * sn) * 0.08838834764831845f, qb = (q1 * sn + q2 * cs) * 0.08838834764831845f, ka = k1 * cs - k2 * sn, kb = k1 * sn + k2 * cs;
    wl[lane] = qa; wl[64 + lane] = qb; wl[128 + lane] = ka; wl[192 + lane] = kb; wl[256 + lane] = bf2f(zp[ZV + lane]); wl[320 + lane] = bf2f(zp[ZV + 64 + lane]);
    const float qk = wave_sum(qa * ka + qb * kb);
    WAVE_LDS_SYNC();
    const float gamma = 1.0f - exp2f(-5.f - (float)h);
    const int e4 = (lane & 31) * 4, half = lane >> 5;
    const f32x4 vv = *(const LAS f32x4*)(wl + 256 + e4);
    f32x4 oacc = (f32x4){0.f, 0.f, 0.f, 0.f};
    const float* s0 = p.in[3] + (size_t)task * 16384 + e4; float* so = p.out + O_RETS + (size_t)task * 16384 + e4;
    f32x4 sv[16];
#pragma unroll
    for (int it = 0; it < 16; ++it) sv[it] = __builtin_nontemporal_load((const f32x4*)(s0 + (32 * part + 2 * it + half) * 128));
#pragma unroll
    for (int it = 0; it < 16; ++it) { const int d = 32 * part + 2 * it + half; const float qd = wl[d], kd = wl[128 + d];
        __builtin_nontemporal_store(sv[it] * gamma + vv * kd, (f32x4*)(so + d * 128)); oacc += sv[it] * qd; }
#pragma unroll
    for (int t = 0; t < 4; ++t) oacc[t] += __shfl_xor(oacc[t], 32);
    if (lane < 32) *(LAS f32x4*)(red + wid * 128 + e4) = oacc;
    __syncthreads();
    if (part == 0) {
        const int w0 = wid;
        oacc = *(const LAS f32x4*)(red + w0 * 128 + e4) + *(const LAS f32x4*)(red + (w0 + 1) * 128 + e4) + *(const LAS f32x4*)(red + (w0 + 2) * 128 + e4) + *(const LAS f32x4*)(red + (w0 + 3) * 128 + e4);
        const f32x4 o = vv * qk + oacc * gamma;
        float s = (o[0] + o[1]) + (o[2] + o[3]);
#pragma unroll
        for (int k = 1; k < 32; k <<= 1) s += __shfl_xor(s, k);
        const float mean = s * (1.f / 128.f); const f32x4 d = o - mean; float v = (d[0] * d[0] + d[1] * d[1]) + (d[2] * d[2] + d[3] * d[3]);
#pragma unroll
        for (int k = 1; k < 32; k <<= 1) v += __shfl_xor(v, k);
        const float rstd = rsqrtf(v * (1.f / 128.f) + EPS);
        if (lane < 32) { const f32x4 gw = *(const f32x4*)(p.in[9] + h * 128 + e4); const u32x2 gr = *(const u32x2*)(zp + ZGR + e4);
            const float g0 = __uint_as_float(gr.x << 16), g1 = __uint_as_float(gr.x & 0xffff0000u), g2 = __uint_as_float(gr.y << 16), g3 = __uint_as_float(gr.y & 0xffff0000u);
            u32x2 w; w.x = cvt_pk_bf16(d[0] * rstd * gw[0] * siluf_(g0), d[1] * rstd * gw[1] * siluf_(g1)); w.y = cvt_pk_bf16(d[2] * rstd * gw[2] * siluf_(g2), d[3] * rstd * gw[3] * siluf_(g3));
            *(u32x2*)(zp + ZQ + e4) = w; }
    }
    __syncthreads();
}
__device__ __forceinline__ void attn_sample_pair(const Params& p, LAS unsigned char* lds, int tp, int lane, int wid) {
    const int task = 2 * tp + (wid >> 2), part = wid & 3, b = task >> 2, h = task & 3;
    LAS float* wl = (LAS float*)(lds + wid * 4096); LAS float* red = (LAS float*)(lds + 32768);
    bf16_t* zp = (bf16_t*)(p.ws + WS_Z) + (size_t)(MP + b) * INW + h * 128;
    const int sub = lane & 15, grp = lane >> 4;
    float qv[8]; unpack8(*(const u32x4*)(zp + ZQM + sub * 8), qv);
    const float* kbase = p.in[5] + ((size_t)(b * NMEM + 64 * part) * 4 + h) * 128 + sub * 8;
    f32x4 kv0[16], kv1[16];
#pragma unroll
    for (int it = 0; it < 16; ++it) { const float* kp = kbase + (size_t)(4 * it + grp) * 512; kv0[it] = __builtin_nontemporal_load((const f32x4*)kp); kv1[it] = __builtin_nontemporal_load((const f32x4*)(kp + 4)); }
#pragma unroll
    for (int it = 0; it < 16; ++it) { const f32x4 k0 = kv0[it], k1 = kv1[it];
        float d = (k0[0] * qv[0] + k0[1] * qv[1]) + (k0[2] * qv[2] + k0[3] * qv[3]) + (k1[0] * qv[4] + k1[1] * qv[5]) + (k1[2] * qv[6] + k1[3] * qv[7]);
        d = sum16(d); if (sub == 0) wl[4 * it + grp] = d * 0.08838834764831845f; }
    WAVE_LDS_SYNC();
    const float sc = wl[lane]; const float mx = wave_max(sc); const float pe = __expf(sc - mx); const float sum = wave_sum(pe);
    WAVE_LDS_SYNC();
    wl[lane] = pe;
    WAVE_LDS_SYNC();
    const int e4 = (lane & 31) * 4, half = lane >> 5;
    const float* vbase = p.in[6] + ((size_t)(b * NMEM + 64 * part) * 4 + h) * 128 + e4;
    f32x4 o = (f32x4){0.f, 0.f, 0.f, 0.f};
#pragma unroll
    for (int blk = 0; blk < 2; ++blk) { f32x4 vv[16];
#pragma unroll
        for (int it = 0; it < 16; ++it) vv[it] = __builtin_nontemporal_load((const f32x4*)(vbase + (size_t)(32 * blk + 2 * it + half) * 512));
#pragma unroll
        for (int it = 0; it < 16; ++it) o += vv[it] * wl[32 * blk + 2 * it + half]; }
#pragma unroll
    for (int t = 0; t < 4; ++t) o[t] += __shfl_xor(o[t], 32);
    if (lane < 32) *(LAS f32x4*)(red + wid * 136 + e4) = o;
    if (lane == 0) { red[wid * 136 + 128] = mx; red[wid * 136 + 129] = sum; }
    __syncthreads();
    if (part == 0) {
        float m4[4], s4[4]; float M = -3.0e38f;
#pragma unroll
        for (int k = 0; k < 4; ++k) { m4[k] = red[(wid + k) * 136 + 128]; s4[k] = red[(wid + k) * 136 + 129]; M = fmaxf(M, m4[k]); }
        float tot = 0.f; f32x4 oo = (f32x4){0.f, 0.f, 0.f, 0.f};
#pragma unroll
        for (int k = 0; k < 4; ++k) { const float f = __expf(m4[k] - M); tot += s4[k] * f; oo += *(const LAS f32x4*)(red + (wid + k) * 136 + e4) * f; }
        const float is = 1.0f / tot;
        if (lane < 32) { const u32x2 gr = *(const u32x2*)(zp + ZGM + e4);
            const float g0 = __uint_as_float(gr.x << 16), g1 = __uint_as_float(gr.x & 0xffff0000u), g2 = __uint_as_float(gr.y << 16), g3 = __uint_as_float(gr.y & 0xffff0000u);
            u32x2 w; w.x = cvt_pk_bf16(oo[0] * is * siluf_(g0), oo[1] * is * siluf_(g1)); w.y = cvt_pk_bf16(oo[2] * is * siluf_(g2), oo[3] * is * siluf_(g3));
            *(u32x2*)(zp + ZQM + e4) = w; }
    }
    __syncthreads();
}
__device__ __forceinline__ void conv_sample_task(const Params& p, int b, int lane) {
    bf16_t* zp = (bf16_t*)(p.ws + WS_Z) + (size_t)(MP + b) * INW; const int c0 = lane * 8;
    const float* sc = p.in[4] + (size_t)b * 30 * 512 + c0; float* so = p.out + O_CONVS + (size_t)b * 30 * 512 + c0; const float* cw = p.in[10] + c0;
    f32x4 y0 = *(const f32x4*)(p.in[11] + c0), y1 = *(const f32x4*)(p.in[11] + c0 + 4);
#pragma unroll 10
    for (int k = 0; k < 30; ++k) { const f32x4 f0 = *(const f32x4*)(sc + k * 512), f1 = *(const f32x4*)(sc + k * 512 + 4), w0 = *(const f32x4*)(cw + k * 512), w1 = *(const f32x4*)(cw + k * 512 + 4);
        y0 += w0 * f0; y1 += w1 * f1; if (k > 0) { *(f32x4*)(so + (k - 1) * 512) = f0; *(f32x4*)(so + (k - 1) * 512 + 4) = f1; } }
    { float a[8], g[8]; unpack8(*(const u32x4*)(zp + ZA + c0), a); unpack8(*(const u32x4*)(zp + ZB + c0), g);
      f32x4 u0, u1;
#pragma unroll
      for (int t = 0; t < 4; ++t) { u0[t] = a[t] * sigmoidf_(g[t]); u1[t] = a[t + 4] * sigmoidf_(g[t + 4]); }
      const f32x4 w0 = *(const f32x4*)(cw + 30 * 512), w1 = *(const f32x4*)(cw + 30 * 512 + 4); y0 += w0 * u0; y1 += w1 * u1;
      *(f32x4*)(so + 29 * 512) = u0; *(f32x4*)(so + 29 * 512 + 4) = u1; }
    const float mean = wave_sum((y0[0] + y0[1]) + (y0[2] + y0[3]) + (y1[0] + y1[1]) + (y1[2] + y1[3])) * (1.f / 512.f);
    const f32x4 d0 = y0 - mean, d1 = y1 - mean;
    const float rstd = rsqrtf(wave_sum((d0[0] * d0[0] + d0[1] * d0[1]) + (d0[2] * d0[2] + d0[3] * d0[3]) + (d1[0] * d1[0] + d1[1] * d1[1]) + (d1[2] * d1[2] + d1[3] * d1[3])) * (1.f / 512.f) + EPS);
    const f32x4 w0 = *(const f32x4*)(p.in[12] + c0), w1 = *(const f32x4*)(p.in[12] + c0 + 4), b0 = *(const f32x4*)(p.in[13] + c0), b1 = *(const f32x4*)(p.in[13] + c0 + 4);
    float g[8], o[8]; unpack8(*(const u32x4*)(zp + ZGC + c0), g);
#pragma unroll
    for (int t = 0; t < 8; ++t) { const float y = (t < 4 ? d0[t & 3] : d1[t & 3]) * rstd * (t < 4 ? w0[t & 3] : w1[t & 3]) + (t < 4 ? b0[t & 3] : b1[t & 3]); o[t] = siluf_(y) * siluf_(g[t]); }
    *(u32x4*)(zp + ZGC + c0) = pack8(o);
}
__device__ __forceinline__ void br_sample_tile(const Params& p, int tile, int lane) {
    const int rt = tile >> 6, ct = tile & 63, r = lane & 15, q = lane >> 4;
    bf16_t* Z = (bf16_t*)(p.ws + WS_Z); const bf16_t* W = (const bf16_t*)(p.ws + WS_WTBR);
    const bf16_t* arow = Z + (size_t)(MP + 16 * rt + r) * INW + 8 * q;
    float tot[4] = {0.f, 0.f, 0.f, 0.f};
#pragma unroll
    for (int br = 0; br < 3; ++br) { const int acol = br == 0 ? ZQ : (br == 1 ? ZGC : ZQM); const bf16_t* wrow = W + (size_t)(br * 1024 + 16 * ct + r) * 512 + 8 * q;
        f32x4 acc = (f32x4){0.f, 0.f, 0.f, 0.f};
#pragma unroll
        for (int ks = 0; ks < 16; ++ks) { const bf16x8 a = *(const bf16x8*)(arow + acol + 32 * ks), bb = *(const bf16x8*)(wrow + 32 * ks); acc = MFMA16(a, bb, acc); }
#pragma unroll
        for (int i = 0; i < 4; ++i) { const float g = bf2f(Z[(size_t)(MP + 16 * rt + 4 * q + i) * INW + ZG0 + br * 1024 + 16 * ct + r]); tot[i] += sigmoidf_(g) * acc[i]; } }
#pragma unroll
    for (int i = 0; i < 4; ++i) Z[(size_t)(MP + 16 * rt + 4 * q + i) * INW + ZG2 + 16 * ct + r] = f2bf(tot[i]);
}
__device__ __forceinline__ void out_sample_tile(const Params& p, int tile, int lane) {
    const int rt = tile >> 6, ct = tile & 63, r = lane & 15, q = lane >> 4;
    const bf16_t* Z = (const bf16_t*)(p.ws + WS_Z); const bf16_t* W = (const bf16_t*)(p.ws + WS_WTOUT);
    const bf16_t* arow = Z + (size_t)(MP + 16 * rt + r) * INW + ZG2 + 8 * q; const bf16_t* wrow = W + (size_t)(16 * ct + r) * DM + 8 * q;
    f32x4 acc = (f32x4){0.f, 0.f, 0.f, 0.f};
#pragma unroll 16
    for (int ks = 0; ks < 32; ++ks) { const bf16x8 a = *(const bf16x8*)(arow + 32 * ks), bb = *(const bf16x8*)(wrow + 32 * ks); acc = MFMA16(a, bb, acc); }
    float* ss = (float*)(p.ws + WS_SS) + MP;
#pragma unroll
    for (int i = 0; i < 4; ++i) { const int row = 16 * rt + 4 * q + i; const size_t off = (size_t)row * DM + 16 * ct + r; const float v = p.in[1][off] + acc[i]; p.out[O_YS + off] = v;
        const float s2 = sum16(v * v); if (r == 0) atomicAdd(ss + row, s2); }
}
__device__ __forceinline__ void final_norm_row(float* yrow, const float* fw, float ssv, int lane) {
    const float rstd = rsqrtf(ssv * (1.f / DM) + EPS); f32x4* yr = (f32x4*)yrow + lane; const f32x4* wr = (const f32x4*)fw + lane;
#pragma unroll
    for (int j = 0; j < 4; ++j) { const f32x4 v = yr[64 * j], w = wr[64 * j]; yr[64 * j] = v * rstd * w; }
}

__global__ void __launch_bounds__(512, 2) mega_fwd(Params p) {
    extern __shared__ __attribute__((aligned(16))) unsigned char lds_raw[];
    LAS unsigned char* lds = (LAS unsigned char*)lds_raw;
    const int tid = threadIdx.x, lane = tid & 63, wid = __builtin_amdgcn_readfirstlane(tid >> 6);
    const int G = gridDim.x, c = blockIdx.x;
    const int gw = c * 8 + wid, NGW = G * 8;
    unsigned char* ws = p.ws;
    bf16_t* XN = (bf16_t*)(p.out + O_YP);
    float* SS = (float*)(ws + WS_SS);
    volatile LAS unsigned* bst = (volatile LAS unsigned*)(lds + LDS_BYTES - 64);
    if (tid < 2) bst[tid] = 0u;
    __syncthreads();
    const XcdBarrier bar = xcd_barrier_post((unsigned*)(ws + WS_BAR), bst);
    const int vw = wid * G + c;

    {
        LAS float* scr = (LAS float*)(lds + wid * 16384);
        constexpr int I_IN = 16 * 240, I_KV = 16 * 32, I_BR = 8 * 32, I_OUT = 16 * 32, NIT = I_IN + I_KV + 3 * I_BR + I_OUT;
        for (int it = gw; it < NIT; it += NGW) {
            int r = it;
            if (r < I_IN) { p0_transpose_item(p.in[8], DM, INW, (bf16_t*)(ws + WS_WT1), 0, scr, r, lane); continue; } r -= I_IN;
            if (r < I_KV) { p0_transpose_item(p.in[15], DM, 1024, (bf16_t*)(ws + WS_WT1), INW, scr, r, lane); continue; } r -= I_KV;
            if (r < I_BR) { p0_transpose_item(p.in[16], 512, 1024, (bf16_t*)(ws + WS_WTBR), 0, scr, r, lane); continue; } r -= I_BR;
            if (r < I_BR) { p0_transpose_item(p.in[17], 512, 1024, (bf16_t*)(ws + WS_WTBR), 1024, scr, r, lane); continue; } r -= I_BR;
            if (r < I_BR) { p0_transpose_item(p.in[18], 512, 1024, (bf16_t*)(ws + WS_WTBR), 2048, scr, r, lane); continue; } r -= I_BR;
            p0_transpose_item(p.in[19], DM, 1024, (bf16_t*)(ws + WS_WTOUT), 0, scr, r, lane);
        }
        for (int m = gw; m < MXN; m += NGW) {
            bf16_t* orow = XN + (size_t)m * DM;
            if (m < MP) rms_row_to_bf16(p.in[0] + (size_t)m * DM, p.in[7], orow, lane);
            else if (m < MP + BS) rms_row_to_bf16(p.in[1] + (size_t)(m - MP) * DM, p.in[7], orow, lane);
            else if (m < MZ) { u32x2* o8 = (u32x2*)orow + lane;
#pragma unroll
                for (int j = 0; j < 4; ++j) o8[64 * j] = (u32x2){0u, 0u}; }
            else rms_row_to_bf16(p.in[2] + (size_t)(m - MZ) * DM, p.in[14], orow, lane);
        }
        float* COS = (float*)(ws + WS_COS); float* SIN = (float*)(ws + WS_SIN);
        for (int idx = c * 512 + tid; idx < 2049 * 64; idx += G * 512) { const int pp = idx >> 6, i = idx & 63; const double pos = pp < 2048 ? (double)pp : 16384.0;
            const double inv = exp2(-(double)i * (13.287712379549449 / 64.0));
            double rev = pos * inv * 0.15915494309189535; rev -= rint(rev);
            COS[idx] = __builtin_amdgcn_cosf((float)rev); SIN[idx] = __builtin_amdgcn_sinf((float)rev); }
    }
    xcd_barrier(bar);

    {
        pg8::Gemm g{DM, DM, DM}; SchedZ S{G, c, (const char*)XN, (const char*)(ws + WS_WT1)};
        EpiZ E{(bf16_t*)(ws + WS_Z), p.out + O_MK, p.out + O_MV, (bf16_t*)(ws + WS_KB), (bf16_t*)(ws + WS_VTG)};
        pg8::gemm_phase<EpiZ, SchedZ, true>(lds, g, S, E);
    }
    xcd_barrier(bar);

    {
        for (int t = c; t < 512; t += G) kv_task(p, lds, t, tid, lane, wid);
        for (int t = c; t < 256; t += G) ret_sample_pair(p, lds, t, lane, wid);
        for (int t = c; t < 512; t += G) conv_task(p, lds, t, tid, lane, wid);
        for (int t = c; t < 256; t += G) attn_sample_pair(p, lds, t, lane, wid);
        for (int t = c; t < 512; t += G) attn_task(p, lds, t, lane, wid);
        for (int t = vw; t < 128; t += NGW) conv_sample_task(p, t, lane);
    }
    xcd_barrier(bar);

    {
        const float* KVT = p.out + O_YP; bf16_t* ST = (bf16_t*)((unsigned char*)(p.out + O_YP) + 32 * MiB);
        for (int idx = c * 512 + tid; idx < 32 * 4096; idx += G * 512) { const int bh = idx >> 12, rem = idx & 4095, e = rem >> 5, d4 = (rem & 31) * 4, h = bh & 3;
            const float cdec = expf(128.f * log1pf(-exp2f(-5.f - (float)h)));
            const float* kp = KVT + (size_t)bh * 16 * 16384 + e * 128 + d4; f32x4 kv[16];
#pragma unroll
            for (int m = 0; m < 16; ++m) kv[m] = *(const f32x4*)(kp + (size_t)m * 16384);
            f32x4 s = (f32x4){0.f, 0.f, 0.f, 0.f};
#pragma unroll
            for (int m = 0; m < 16; ++m) { if (m > 0) { u32x2 w; w.x = cvt_pk_bf16(s[0], s[1]); w.y = cvt_pk_bf16(s[2], s[3]); *(u32x2*)(ST + ((size_t)bh * 16 + m) * 16384 + e * 128 + d4) = w; }
                s = s * cdec + kv[m]; }
            float* rp = p.out + O_RETP + (size_t)bh * 16384 + e;
#pragma unroll
            for (int t = 0; t < 4; ++t) rp[(size_t)(d4 + t) * 128] = s[t]; }
    }
    xcd_barrier(bar);

    {
        for (int t = c; t < 512; t += G) o_task(p, lds, t, tid, lane, wid);
        for (int t = vw; t < 512; t += NGW) br_sample_tile(p, t, lane);
    }
    xcd_barrier(bar);

    {
        pg8::Gemm g{512, INW, 512}; SchedBr S{G, c, (const char*)(ws + WS_Z), (const char*)(ws + WS_WTBR)};
        EpiBr E{(bf16_t*)(ws + WS_Z)};
        pg8::gemm_phase<EpiBr, SchedBr, true>(lds, g, S, E);
        for (int t = vw; t < 512; t += NGW) out_sample_tile(p, t, lane);
    }
    xcd_barrier(bar);

    {
        pg8::Gemm g{DM, INW, DM}; SchedOut S{G, c, (const char*)(ws + WS_Z), (const char*)(ws + WS_WTOUT)};
        EpiOut E{p.in[0], p.out + O_YP, SS};
        pg8::gemm_phase<EpiOut, SchedOut, false>(lds, g, S, E);
        for (int m = vw; m < BS; m += NGW) final_norm_row(p.out + O_YS + (size_t)m * DM, p.in[20], __hip_atomic_load(SS + MP + m, __ATOMIC_RELAXED, __HIP_MEMORY_SCOPE_AGENT), lane);
    }
    xcd_barrier(bar);

    for (int m = gw; m < MP; m += NGW) final_norm_row(p.out + O_YP + (size_t)m * DM, p.in[20], __hip_atomic_load(SS + m, __ATOMIC_RELAXED, __HIP_MEMORY_SCOPE_AGENT), lane);
}

extern "C" void kernel_launch(void* const* d_in, const int* in_sizes, int n_in, void* d_out, int out_size, void* d_ws, size_t ws_size, hipStream_t stream) {
    static int grid = 0;
    if (grid == 0) {
        if (n_in != 21 || ws_size < WS_END) { fprintf(stderr, "kernel_launch: need 21 inputs and >= %zu bytes of workspace; got %d, %zu\n", (size_t)WS_END, n_in, ws_size); grid = -1; return; }
        int dev = 0, cus = 0, per_cu = 0;
        if (hipGetDevice(&dev) != hipSuccess || hipDeviceGetAttribute(&cus, hipDeviceAttributeMultiprocessorCount, dev) != hipSuccess) { grid = -1; return; }
        if (hipFuncSetAttribute((const void*)mega_fwd, hipFuncAttributeMaxDynamicSharedMemorySize, LDS_BYTES) != hipSuccess) { fprintf(stderr, "kernel_launch: hipFuncSetAttribute failed\n"); grid = -1; return; }
        if (hipOccupancyMaxActiveBlocksPerMultiprocessor(&per_cu, (const void*)mega_fwd, 512, LDS_BYTES) != hipSuccess || per_cu < 1) { fprintf(stderr, "kernel_launch: occupancy query reports %d blocks per CU\n", per_cu); grid = -1; return; }
        grid = cus;
    }
    if (grid < 0) return;
    Params p{};
    for (int i = 0; i < 21; ++i) p.in[i] = (const float*)d_in[i];
    p.out = (float*)d_out; p.ws = (unsigned char*)d_ws;
    if (hipMemsetAsync(d_ws, 0, WS_ZERO_BYTES, stream) != hipSuccess) { fprintf(stderr, "kernel_launch: hipMemsetAsync failed\n"); return; }
    void* args[] = {&p};
    hipError_t e = hipLaunchCooperativeKernel((const void*)mega_fwd, dim3(grid), dim3(512), args, LDS_BYTES, stream);
    if (e != hipSuccess) fprintf(stderr, "kernel_launch: cooperative launch failed: %s (grid %d)\n", hipGetErrorString(e), grid);
}
```
